# Optimizing an MI355X kernel written in HIP

```python
import math
import jax, jax.numpy as jnp
from jax import lax
import numpy as np

D_MODEL = 1024
BATCH = 4
SEQ = 4096
DEPTH = 2

N_HEADS_A = 4
HEAD_DIM_A = 64
W_A = N_HEADS_A * 2 * HEAD_DIM_A
N_HEADS_B = 4
HEAD_DIM_B = D_MODEL // 8
W_B = N_HEADS_B * HEAD_DIM_B
CONV_W = 4
Q_BLOCK = 128
MLSTM_CHUNK = 64
EPS = 1e-6
N_IN = 4 * W_A + 5 * W_B + 2 * N_HEADS_B + 2 * D_MODEL

kernel_name = "hybrid_diffattn_mlstm_gated_merge"


def _rmsnorm(x, g):
    xf = x.astype(jnp.float32)
    y = xf * lax.rsqrt(jnp.mean(xf * xf, axis=-1, keepdims=True) + EPS)
    return (y * g.astype(jnp.float32)).astype(x.dtype)


def _split(t, sizes):
    idx = np.cumsum(sizes)[:-1].tolist()
    return jnp.split(t, idx, axis=-1)


def _causal_conv(x, w):
    S = x.shape[1]
    xp = jnp.pad(x, ((0, 0), (CONV_W - 1, 0), (0, 0)))
    y = xp[:, 0:S] * w[0]
    for k in range(1, CONV_W):
        y = y + xp[:, k:k + S] * w[k]
    return y


def _alibi_slopes(n_heads):
    return 2.0 ** (-8.0 * jnp.arange(1, n_heads + 1, dtype=jnp.float32) / n_heads)


def _diff_attention(q, k, v, lam):
    B, S, _ = q.shape
    H, d = N_HEADS_A, HEAD_DIM_A
    qh = q.reshape(B, S, H, 2, d).transpose(0, 2, 3, 1, 4)
    kh = k.reshape(B, S, H, 2, d).transpose(0, 2, 3, 1, 4)
    vh = v.reshape(B, S, H, 2 * d).transpose(0, 2, 1, 3)
    nb = S // Q_BLOCK
    q_blocks = qh.reshape(B, H, 2, nb, Q_BLOCK, d).transpose(3, 0, 1, 2, 4, 5)
    slopes = _alibi_slopes(H)
    s_pos = jnp.arange(S)
    scale = d ** -0.5

    def block(args):
        q_blk, i = args
        t_pos = i * Q_BLOCK + jnp.arange(Q_BLOCK)
        dist = (t_pos[:, None] - s_pos[None, :]).astype(jnp.float32)
        bias = jnp.where(dist >= 0, -slopes[:, None, None] * dist, -jnp.inf)
        scores = jnp.einsum('bhcqd,bhcsd->bhcqs', q_blk, kh,
                            preferred_element_type=jnp.float32) * scale + bias[None, :, None]
        p = jax.nn.softmax(scores, axis=-1)
        p = p[:, :, 0] - lam * p[:, :, 1]
        return jnp.einsum('bhqs,bhse->bhqe', p.astype(vh.dtype), vh)

    out = lax.map(block, (q_blocks, jnp.arange(nb)))
    return out.transpose(1, 0, 3, 2, 4).reshape(B, S, H, 2 * d)


def _mlstm(q, k, v, ig, fg):
    B, S, _ = q.shape
    H, d, L = N_HEADS_B, HEAD_DIM_B, MLSTM_CHUNK
    nc = S // L

    def heads(t):
        return t.astype(jnp.float32).reshape(B, nc, L, H, d).transpose(1, 0, 3, 2, 4)

    def gates(t):
        return t.astype(jnp.float32).reshape(B, nc, L, H).transpose(1, 0, 3, 2)

    qc, kc, vc = heads(q), heads(k) * (d ** -0.5), heads(v)
    igc = gates(ig)
    lfc = jax.nn.log_sigmoid(gates(fg))
    causal = jnp.tril(jnp.ones((L, L), dtype=bool))

    def body(carry, xs):
        C, n, m = carry
        qj, kj, vj, ij, lj = xs
        b = jnp.cumsum(lj, axis=-1)
        logD = b[..., :, None] - b[..., None, :] + ij[..., None, :]
        logD = jnp.where(causal, logD, -jnp.inf)
        inter = b + m[..., None]
        m_row = jnp.maximum(inter, jnp.max(logD, axis=-1))
        Dm = jnp.exp(logD - m_row[..., None])
        w_inter = jnp.exp(inter - m_row)
        Sm = jnp.einsum('bhjd,bhsd->bhjs', qj, kj) * Dm
        num = jnp.einsum('bhjs,bhse->bhje', Sm, vj) + w_inter[..., None] * jnp.einsum('bhjd,bhde->bhje', qj, C)
        den = jnp.sum(Sm, axis=-1) + w_inter * jnp.einsum('bhjd,bhd->bhj', qj, n)
        h = num / jnp.maximum(jnp.abs(den), jnp.exp(-m_row))[..., None]
        bL = b[..., -1]
        a = bL[..., None] - b + ij
        m_new = jnp.maximum(bL + m, jnp.max(a, axis=-1))
        decay = jnp.exp(bL + m - m_new)
        wk = jnp.exp(a - m_new[..., None])
        C_new = decay[..., None, None] * C + jnp.einsum('bhs,bhsd,bhse->bhde', wk, kj, vj)
        n_new = decay[..., None] * n + jnp.einsum('bhs,bhsd->bhd', wk, kj)
        return (C_new, n_new, m_new), h

    init = (jnp.zeros((B, H, d, d), jnp.float32), jnp.zeros((B, H, d), jnp.float32),
            jnp.zeros((B, H), jnp.float32))
    _, hs = lax.scan(body, init, (qc, kc, vc, igc, lfc))
    return hs.transpose(1, 0, 3, 2, 4).reshape(B, S, H, d)


def setup_inputs(seed: int = 0) -> dict:
    key = jax.random.key(seed)
    ks = jax.random.split(key, 14)
    nrm = jax.random.normal
    x = nrm(ks[0], (BATCH, SEQ, D_MODEL), jnp.float32)
    norm_pre = 1.0 + 0.05 * nrm(ks[1], (DEPTH, D_MODEL), jnp.float32)
    norm_post = 1.0 + 0.05 * nrm(ks[2], (DEPTH, D_MODEL), jnp.float32)
    w_in = nrm(ks[3], (DEPTH, D_MODEL, N_IN), jnp.float32) * D_MODEL ** -0.5
    b_i = 0.1 * nrm(ks[4], (DEPTH, N_HEADS_B), jnp.float32)
    b_f = jnp.linspace(3.0, 6.0, N_HEADS_B, dtype=jnp.float32)[None, :] + 0.01 * nrm(ks[5], (DEPTH, N_HEADS_B), jnp.float32)
    b_if = jnp.concatenate([b_i, b_f], axis=-1)
    conv_qk = nrm(ks[6], (DEPTH, CONV_W, 2 * W_B), jnp.float32) * CONV_W ** -0.5
    lambda_qk = 0.1 * nrm(ks[7], (DEPTH, 4, HEAD_DIM_A), jnp.float32)
    norm_a = 1.0 + 0.05 * nrm(ks[8], (DEPTH, W_A), jnp.float32)
    norm_b = 1.0 + 0.05 * nrm(ks[9], (DEPTH, W_B), jnp.float32)
    w_a = nrm(ks[10], (DEPTH, W_A, D_MODEL), jnp.float32) * W_A ** -0.5
    w_b = nrm(ks[11], (DEPTH, W_B, D_MODEL), jnp.float32) * W_B ** -0.5
    w_out = nrm(ks[12], (DEPTH, D_MODEL, D_MODEL), jnp.float32) * D_MODEL ** -0.5
    return {"x": x, "norm_pre": norm_pre, "norm_post": norm_post, "w_in": w_in,
            "b_if": b_if, "conv_qk": conv_qk, "lambda_qk": lambda_qk,
            "norm_a": norm_a, "norm_b": norm_b, "w_a": w_a, "w_b": w_b, "w_out": w_out}


def reference(x, norm_pre, norm_post, w_in, b_if, conv_qk, lambda_qk, norm_a, norm_b, w_a, w_b, w_out):
    B, S, _ = x.shape
    H_A, H_B = N_HEADS_A, N_HEADS_B
    sizes = [W_A, W_A, W_A, W_A, W_B, W_B, W_B, W_B, W_B, H_B, H_B, D_MODEL, D_MODEL]
    for l in range(DEPTH):
        h = _rmsnorm(x, norm_pre[l])
        proj = jnp.einsum('bsd,dn->bsn', h, w_in[l])
        qa, ka, va, za, qb, kb, vb, ob, zb, igb, fgb, ga, gb = _split(proj, sizes)

        lam_init = 0.8 - 0.6 * math.exp(-0.3 * l)
        lq = lambda_qk[l].astype(jnp.float32)
        lam = jnp.exp(jnp.sum(lq[0] * lq[1])) - jnp.exp(jnp.sum(lq[2] * lq[3])) + lam_init
        oa = _diff_attention(qa, ka, va, lam)
        oa = _rmsnorm(oa, norm_a[l].reshape(H_A, 2 * HEAD_DIM_A)) * (1.0 - lam_init)
        ya = oa.reshape(B, S, W_A) * jax.nn.silu(za)

        qk = jax.nn.silu(_causal_conv(jnp.concatenate([qb, kb], axis=-1), conv_qk[l]))
        qb_c, kb_c = qk[..., :W_B], qk[..., W_B:]
        ig = igb + b_if[l, :H_B]
        fg = fgb + b_if[l, H_B:]
        hb = _mlstm(qb_c, kb_c, vb, ig, fg)
        hb = jax.nn.sigmoid(ob.astype(jnp.float32)).reshape(B, S, H_B, HEAD_DIM_B) * hb
        hb = _rmsnorm(hb, norm_b[l].reshape(H_B, HEAD_DIM_B)).astype(x.dtype)
        yb = hb.reshape(B, S, W_B) * jax.nn.silu(zb)

        merged = (jax.nn.sigmoid(ga) * jnp.einsum('bsw,wd->bsd', ya, w_a[l])
                  + jax.nn.sigmoid(gb) * jnp.einsum('bsw,wd->bsd', yb, w_b[l]))
        out = jnp.einsum('bsd,de->bse', merged, w_out[l])
        x = x + _rmsnorm(out, norm_post[l])
    return x
```

```cpp
#include <hip/hip_runtime.h>
#include <cstdint>
#include <cstdio>
#include <cmath>
#define MK_LAUNCH_MODE 1
namespace mk {
#define LAS __attribute__((address_space(3)))
#define GAS __attribute__((address_space(1)))
typedef unsigned short bf16_t;
typedef short bf16x8 __attribute__((ext_vector_type(8)));
typedef short s16x4 __attribute__((ext_vector_type(4)));
typedef float f32x2 __attribute__((ext_vector_type(2)));
typedef float f32x4 __attribute__((ext_vector_type(4)));
typedef float f32x16 __attribute__((ext_vector_type(16)));
typedef unsigned u32x2 __attribute__((ext_vector_type(2)));
typedef unsigned u32x4 __attribute__((ext_vector_type(4)));
typedef __bf16 bf16x2_t __attribute__((ext_vector_type(2)));
typedef GAS unsigned gu32;

constexpr int D = 1024, SEQ = 4096, NBATCH = 4, M = NBATCH * SEQ, NINR = 6664, NL = 6656, NLA = 4608;
constexpr int LDP = 4608;
constexpr int P_QA = 0, P_KA = 512, P_VA = 1024, P_ZA = 1536, P_QB = 2048, P_KB = 2560, P_VB = 3072, P_OB = 3584, P_ZB = 4096;
constexpr int P_YA = 0, P_YB = 512, P_SGA = 1024, P_SGB = 2048, P_MG = 3072, P_OUT = 1024;
constexpr float EPS = 1e-6f, LOG2E = 1.4426950408889634f, QSCALE = 0.125f * 1.4426950408889634f, KSCALE = 0.08838834764831845f;
constexpr int NWAVES = 8, NTHREADS = 512;

constexpr size_t MiB = 1u << 20;
constexpr size_t WS_CTL = 0, CTL_ZERO_BYTES = 1 * MiB;
constexpr size_t WS_WIN = 1 * MiB;
constexpr size_t WS_WAB = 27 * MiB;
constexpr size_t WS_WOUT = 31 * MiB;
constexpr size_t WS_GATES = 35 * MiB;
constexpr size_t WS_MSC = 35 * MiB + 512 * 1024;
constexpr size_t WS_DN = 36 * MiB;
constexpr size_t WS_HN = 38 * MiB;
constexpr size_t WS_CST = 70 * MiB;
constexpr size_t WS_PROJ = 102 * MiB;
constexpr size_t WS_END = 246 * MiB;
constexpr int CW_BAR = 4096;

constexpr int RING_BYTES = 131072, WSF_OFF = 131072, LDSCTL_OFF = 135168, MISC_OFF = LDSCTL_OFF + 320, LDS_BYTES = 147456;

__device__ __forceinline__ unsigned cvtpk(float lo, float hi) { f32x2 v = {lo, hi}; bf16x2_t b = __builtin_convertvector(v, bf16x2_t); return __builtin_bit_cast(unsigned, b); }
__device__ __forceinline__ float bflo(unsigned u) { return __uint_as_float(u << 16); }
__device__ __forceinline__ float bfhi(unsigned u) { return __uint_as_float(u & 0xffff0000u); }
__device__ __forceinline__ float bf1(bf16_t u) { return __uint_as_float((unsigned)u << 16); }
__device__ __forceinline__ float ex2(float x) { return __builtin_amdgcn_exp2f(x); }
__device__ __forceinline__ float rcp(float x) { return __builtin_amdgcn_rcpf(x); }
__device__ __forceinline__ float sigm(float x) { return rcp(1.f + ex2(-x * LOG2E)); }
__device__ __forceinline__ float silu(float x) { return x * sigm(x); }
__device__ __forceinline__ float wave_sum(float v) {
#pragma unroll
    for (int o = 1; o < 64; o <<= 1) v += __shfl_xor(v, o);
    return v;
}
__device__ __forceinline__ int crow(int r, int hi) { return (r & 3) + 8 * (r >> 2) + 4 * hi; }
#define LDS_WAIT() asm volatile("s_waitcnt lgkmcnt(0)" ::: "memory")
#define VM_WAIT() asm volatile("s_waitcnt vmcnt(0)" ::: "memory")
#define SBAR() __builtin_amdgcn_sched_barrier(0)
#define WG_BAR() do { asm volatile("s_waitcnt vmcnt(0) lgkmcnt(0)\n\ts_barrier" ::: "memory"); } while (0)

#define XB_TMO      128
#define XB_XCNT(j)  (256  + 64 * (j))
#define XB_XSUB(j)  (1280 + 64 * (j))
#define XB_XGEN(j)  (2304 + 64 * (j))
#define XB_TOP      3328
#define XB_TOPGEN   3392
#define XCD_BAR_WORDS 3456
#define XB_SPIN_CAP (1u << 18)
__device__ __forceinline__ unsigned xb_ld(unsigned* p)              { return __hip_atomic_load(p, __ATOMIC_RELAXED, __HIP_MEMORY_SCOPE_AGENT); }
__device__ __forceinline__ unsigned xb_add(unsigned* p, unsigned v) { return __hip_atomic_fetch_add(p, v, __ATOMIC_RELAXED, __HIP_MEMORY_SCOPE_AGENT); }
__device__ __forceinline__ unsigned xb_xcc_id() { return (unsigned)__builtin_amdgcn_s_getreg((3 << 11) | 20) & 0xFu; }
#define XB_SPIN(cond, bar) do { unsigned _sp = 0; while (cond) { __builtin_amdgcn_s_sleep(1); \
    if ((++_sp & 255u) == 0u) { if (xb_ld(&(bar)[XB_TMO])) break; if (_sp > XB_SPIN_CAP) { atomicAdd(&(bar)[XB_TMO], 1u); break; } } } } while (0)
struct XcdBarrier { unsigned* bar; unsigned x; volatile LAS unsigned* st; };
__device__ __forceinline__ XcdBarrier xcd_barrier_post(unsigned* bar, volatile LAS unsigned* st) {
    XcdBarrier b; b.bar = bar; b.x = xb_xcc_id(); b.st = st;
    if (threadIdx.x == 0) (void)xb_add(&bar[XB_XCNT(b.x)], 1u);
    return b;
}
__device__ __forceinline__ void xcd_barrier_complete(unsigned* bar, unsigned x, unsigned& nloc, unsigned& nx) {
    const unsigned G = gridDim.x * gridDim.y * gridDim.z;
    unsigned sum, cnt, mine, sp = 0u;
    for (;;) {
        sum = 0u; cnt = 0u; mine = 0u;
#pragma unroll
        for (unsigned j = 0; j < 16; ++j) { const unsigned c = xb_ld(&bar[XB_XCNT(j)]); sum += c; cnt += (c > 0u) ? 1u : 0u; mine = (j == x) ? c : mine; }
        if (sum == G) break;
        __builtin_amdgcn_s_sleep(1);
        if ((++sp & 255u) == 0u) { if (xb_ld(&bar[XB_TMO])) break; if (sp > XB_SPIN_CAP) { atomicAdd(&bar[XB_TMO], 1u); break; } }
    }
    nloc = mine > 0u ? mine : 1u; nx = cnt > 0u ? cnt : 1u;
}
__device__ __forceinline__ void xcd_barrier(const XcdBarrier& b) {
    asm volatile("s_waitcnt vmcnt(0)" ::: "memory");
    __syncthreads();
    if (threadIdx.x == 0) {
        unsigned* bar = b.bar;
        __builtin_amdgcn_s_waitcnt(0);
        unsigned nloc = b.st[0], nx = b.st[1];
        if (nloc == 0u) { xcd_barrier_complete(bar, b.x, nloc, nx); b.st[0] = nloc; b.st[1] = nx; }
        const unsigned old = xb_add(&bar[XB_XSUB(b.x)], 1u);
        const unsigned gen = old / nloc;
        if (old + 1u == (gen + 1u) * nloc) {
            __builtin_amdgcn_fence(__ATOMIC_RELEASE, "agent");
            asm volatile("s_waitcnt vmcnt(0)" ::: "memory");
            const unsigned og = xb_add(&bar[XB_TOP], 1u);
            const unsigned tg = og / nx;
            if (og + 1u == (tg + 1u) * nx) xb_add(&bar[XB_TOPGEN], 1u);
            else XB_SPIN(xb_ld(&bar[XB_TOPGEN]) == tg, bar);
            __builtin_amdgcn_fence(__ATOMIC_ACQUIRE, "agent");
            xb_add(&bar[XB_XGEN(b.x)], 1u);
            asm volatile("s_waitcnt vmcnt(0)" ::: "memory");
        } else {
            XB_SPIN(xb_ld(&bar[XB_XGEN(b.x)]) == gen, bar);
            __builtin_amdgcn_fence(__ATOMIC_ACQUIRE, "agent");
            asm volatile("s_waitcnt vmcnt(0)" ::: "memory");
        }
    }
    __syncthreads();
}

constexpr int BM = 256, BK = 64, HALF = 128, HTB = HALF * BK * 2, NXCD = 8, WGM = 8;
__host__ __device__ __forceinline__ int lds_byte(int r, int c) { const int st = (r >> 4) * 2 + (c >> 5), rr = r & 15, cc = c & 31, ob = rr * 64 + cc * 2; return st * 1024 + (ob ^ (((ob >> 9) & 1) << 5)); }
__host__ __device__ __forceinline__ void stage_rc(int b, int& R, int& C) { const int st = b / 1024, sb = b % 1024, swz = sb ^ (((sb >> 9) & 1) << 5); R = (st >> 1) * 16 + swz / 64; C = (st & 1) * 32 + (swz % 64) / 2; }
__host__ __device__ __forceinline__ int perm32(int rho) { const int n = rho >> 4, i = rho & 15; return 8 * (i >> 2) + 4 * n + (i & 3); }
struct Unit { int pm, pn; };
struct Gemm { const bf16_t* A; const bf16_t* Bt; int M, N, K, lda; };
struct StaticOrder {
    int nM, nN, nwg, G, c;
    __device__ void init(int M_, int N_, int G_, int c_) { nM = M_ / BM; nN = N_ / BM; nwg = nM * nN; G = G_; c = c_; }
    __device__ bool next(int i, Unit& u) const {
        const long L = (long)i * G + c; if (L >= nwg) return false;
        int wgid = (int)L; { const int q = nwg / NXCD, r = nwg % NXCD, xcd = wgid % NXCD, off = wgid / NXCD; wgid = (xcd < r ? xcd * (q + 1) : r * (q + 1) + (xcd - r) * q) + off; }
        const int nig = WGM * nN, gid = wgid / nig, fm = gid * WGM, gsz = (nM - fm) < WGM ? (nM - fm) : WGM;
        u.pm = fm + ((wgid % nig) % gsz); u.pn = (wgid % nig) / gsz; return true;
    }
};
template <int MODE> struct Epi {
    static constexpr bool MID = (MODE == 2);
    bf16_t* O; int ldc; const bf16_t* GA; const bf16_t* GB;
    __device__ __forceinline__ void operator()(const f32x4 (&acc)[2][2][4][2], const Unit& u, int wr, int wc, int fr_, int fq_) const {
        int fr = fr_, fq = fq_; asm volatile("" : "+v"(fr), "+v"(fq));
        const int row0 = u.pm * BM + wr * 64 + fr, col0 = u.pn * BM + wc * 32 + 8 * fq;
#pragma unroll
        for (int ai = 0; ai < 2; ++ai)
#pragma unroll
            for (int m = 0; m < 4; ++m) { const size_t ro = (size_t)(row0 + ai * HALF + m * 16) * ldc + col0;
#pragma unroll
                for (int bj = 0; bj < 2; ++bj) { f32x4 v0 = acc[ai][bj][m][0], v1 = acc[ai][bj][m][1];
                    if (MODE == 1) {
#pragma unroll
                        for (int j = 0; j < 4; ++j) { v0[j] = sigm(v0[j]); v1[j] = sigm(v1[j]); } }
                    if (MODE == 2) { const u32x4 g = *(const u32x4*)(GB + ro + bj * HALF);
                        v0[0] *= bflo(g.x); v0[1] *= bfhi(g.x); v0[2] *= bflo(g.y); v0[3] *= bfhi(g.y); v1[0] *= bflo(g.z); v1[1] *= bfhi(g.z); v1[2] *= bflo(g.w); v1[3] *= bfhi(g.w); }
                    u32x4 w; w.x = cvtpk(v0[0], v0[1]); w.y = cvtpk(v0[2], v0[3]); w.z = cvtpk(v1[0], v1[1]); w.w = cvtpk(v1[2], v1[3]);
                    *(u32x4*)(O + ro + bj * HALF) = w; }
                if (MODE == 2) asm volatile("" ::: "memory"); }
    }
    __device__ __forceinline__ void mid(f32x4 (&acc)[2][2][4][2], const Unit& u, int wr, int wc, int fr_, int fq_) const {
        int fr = fr_, fq = fq_; asm volatile("" : "+v"(fr), "+v"(fq));
        const int row0 = u.pm * BM + wr * 64 + fr, col0 = u.pn * BM + wc * 32 + 8 * fq;
#pragma unroll
        for (int ai = 0; ai < 2; ++ai)
#pragma unroll
            for (int m = 0; m < 4; ++m) { const size_t ro = (size_t)(row0 + ai * HALF + m * 16) * ldc + col0;
#pragma unroll
                for (int bj = 0; bj < 2; ++bj) { const u32x4 a = *(const u32x4*)(GA + ro + bj * HALF), g = *(const u32x4*)(GB + ro + bj * HALF);
                    f32x4& v0 = acc[ai][bj][m][0]; f32x4& v1 = acc[ai][bj][m][1];
                    v0[0] *= bflo(a.x) * rcp(bflo(g.x)); v0[1] *= bfhi(a.x) * rcp(bfhi(g.x)); v0[2] *= bflo(a.y) * rcp(bflo(g.y)); v0[3] *= bfhi(a.y) * rcp(bfhi(g.y));
                    v1[0] *= bflo(a.z) * rcp(bflo(g.z)); v1[1] *= bfhi(a.z) * rcp(bfhi(g.z)); v1[2] *= bflo(a.w) * rcp(bflo(g.w)); v1[3] *= bfhi(a.w) * rcp(bfhi(g.w)); }
                asm volatile("" ::: "memory"); }
    }
};

template <class EpiT, bool ALIGN_EPI>
__device__ __forceinline__ void gemm_phase(LAS unsigned char* lds, const Gemm g, const StaticOrder& S, const EpiT& E) {
    int tid_ = threadIdx.x; asm volatile("" : "+v"(tid_));
    const int tid = tid_, wid = __builtin_amdgcn_readfirstlane(tid >> 6), lane = tid & 63, wr = wid >> 2, wc = wid & 3, fr = lane & 15, fq = lane >> 4;
    const int K = g.K, nt = K / BK, lda = g.lda;
    unsigned voffA[2], voffB[2];
#pragma unroll
    for (int i = 0; i < 2; ++i) { int R, C; stage_rc(tid * 16 + i * 8192, R, C); const int Rb = (R & ~31) + perm32(R & 31);
        voffA[i] = (unsigned)(R * lda + C) * 2u; voffB[i] = (unsigned)(Rb * K + C) * 2u; }
    const size_t kstep = (size_t)(BK * 2);
    const size_t hsA = (size_t)HALF * lda * 2, hsB = (size_t)HALF * K * 2, tsA = 2 * hsA, tsB = 2 * hsB;
    const unsigned ldsw = (unsigned)wid * 1024u;
    const int aoff = lds_byte(wr * 64 + fr, fq * 8), boff = lds_byte(wc * 32 + fr, fq * 8);
#define PG8_SA(b, h) (((b) * 2 + (h)) * HTB)
#define PG8_SB(b, h) ((4 + (b) * 2 + (h)) * HTB)
#define PG8_STAGE(bufoff, gbase, voff) do { _Pragma("unroll") for (int _i = 0; _i < 2; ++_i) \
        __builtin_amdgcn_global_load_lds((const unsigned*)((const char*)(gbase) + (voff)[_i]), (LAS unsigned*)(lds + (bufoff) + ldsw + _i * 8192), 16, 0, 0); } while (0)
#define PG8_LDA(dst, b, h) do { _Pragma("unroll") for (int m = 0; m < 4; ++m) _Pragma("unroll") for (int k = 0; k < 2; ++k) dst[m][k] = *(const LAS bf16x8*)(lds + PG8_SA(b, h) + aoff + m * 2048 + k * 1024); } while (0)
#define PG8_LDB(dst, b, h) do { _Pragma("unroll") for (int n = 0; n < 2; ++n) _Pragma("unroll") for (int k = 0; k < 2; ++k) dst[n][k] = *(const LAS bf16x8*)(lds + PG8_SB(b, h) + boff + n * 2048 + k * 1024); } while (0)
#define PG8_MMA(ai, bj, At, Bt) do { __builtin_amdgcn_s_setprio(1); _Pragma("unroll") for (int m = 0; m < 4; ++m) _Pragma("unroll") for (int n = 0; n < 2; ++n) _Pragma("unroll") for (int k = 0; k < 2; ++k) \
        acc[ai][bj][m][n] = __builtin_amdgcn_mfma_f32_16x16x32_bf16(Bt[n][k], At[m][k], acc[ai][bj][m][n], 0, 0, 0); __builtin_amdgcn_s_setprio(0); } while (0)
#define PG8_WAIT_V(n) asm volatile("s_waitcnt vmcnt(" #n ")" ::: "memory")
#define PG8_WAIT_L(n) asm volatile("s_waitcnt lgkmcnt(" #n ")" ::: "memory")
#define PG8_BAR __builtin_amdgcn_s_barrier()
#define PG8_SCHED __builtin_amdgcn_sched_barrier(0)
    Unit cur, nxt; int ui = 0;
    if (!S.next(0, cur)) return;
    f32x4 acc[2][2][4][2];
#pragma unroll
    for (int a = 0; a < 2; ++a)
#pragma unroll
        for (int b = 0; b < 2; ++b)
#pragma unroll
            for (int m = 0; m < 4; ++m)
#pragma unroll
                for (int n = 0; n < 2; ++n) acc[a][b][m][n] = (f32x4){0.f, 0.f, 0.f, 0.f};
    bf16x8 At[4][2], B0[2][2], B1[2][2];
    const char* cA = (const char*)g.A + (size_t)cur.pm * tsA; const char* cB = (const char*)g.Bt + (size_t)cur.pn * tsB;
    PG8_STAGE(PG8_SB(0, 0), cB, voffB); PG8_STAGE(PG8_SB(0, 1), cB + hsB, voffB); PG8_STAGE(PG8_SA(0, 0), cA, voffA); PG8_STAGE(PG8_SA(0, 1), cA + hsA, voffA);
    if (wr == 1) PG8_BAR;
    PG8_WAIT_V(2); PG8_BAR;
    PG8_STAGE(PG8_SB(1, 0), cB + kstep, voffB); PG8_STAGE(PG8_SA(1, 0), cA + kstep, voffA); PG8_STAGE(PG8_SB(1, 1), cB + hsB + kstep, voffB);
    PG8_WAIT_V(6); PG8_BAR;
    for (;;) {
        const bool has_next = S.next(ui + 1, nxt);
        const char* nA = has_next ? (const char*)g.A + (size_t)nxt.pm * tsA : cA; const char* nB = has_next ? (const char*)g.Bt + (size_t)nxt.pn * tsB : cB;
        for (int t = 0; t < nt; t += 2) {
            const bool last = (t == nt - 2);
            const char* a1 = cA + (size_t)(t + 1) * kstep;
            const char* a2 = last ? nA : cA + (size_t)(t + 2) * kstep; const char* b2 = last ? nB : cB + (size_t)(t + 2) * kstep;
            const char* a3 = a2 + kstep; const char* b3 = b2 + kstep;
            if constexpr (EpiT::MID) { if (t == nt / 2) E.mid(acc, cur, wr, wc, fr, fq); }
            PG8_LDB(B0, 0, 0); PG8_LDB(B1, 0, 1); PG8_SCHED; PG8_LDA(At, 0, 0); PG8_STAGE(PG8_SA(1, 1), a1 + hsA, voffA);
            PG8_WAIT_V(8); PG8_WAIT_L(0); PG8_BAR; PG8_MMA(0, 0, At, B0); PG8_MMA(0, 1, At, B1); PG8_BAR; PG8_SCHED;
            PG8_LDA(At, 0, 1); PG8_STAGE(PG8_SB(0, 0), b2, voffB); PG8_STAGE(PG8_SB(0, 1), b2 + hsB, voffB); PG8_STAGE(PG8_SA(0, 0), a2, voffA);
            PG8_WAIT_V(8); PG8_WAIT_L(0); PG8_BAR; PG8_MMA(1, 0, At, B0); PG8_MMA(1, 1, At, B1); PG8_BAR; PG8_SCHED;
            PG8_LDB(B0, 1, 0); PG8_LDB(B1, 1, 1); PG8_SCHED; PG8_LDA(At, 1, 0); PG8_STAGE(PG8_SA(0, 1), a2 + hsA, voffA);
            PG8_WAIT_V(8); PG8_WAIT_L(0); PG8_BAR; PG8_MMA(0, 0, At, B0); PG8_MMA(0, 1, At, B1); PG8_BAR; PG8_SCHED;
            PG8_LDA(At, 1, 1); PG8_STAGE(PG8_SB(1, 0), b3, voffB); PG8_STAGE(PG8_SB(1, 1), b3 + hsB, voffB); PG8_STAGE(PG8_SA(1, 0), a3, voffA);
            PG8_WAIT_V(8); PG8_WAIT_L(0); PG8_BAR; PG8_MMA(1, 0, At, B0); PG8_MMA(1, 1, At, B1); PG8_BAR; PG8_SCHED;
        }
        if constexpr (ALIGN_EPI) { if (wr == 0) PG8_BAR; }
        E(acc, cur, wr, wc, fr, fq);
        if (!has_next) break;
#pragma unroll
        for (int a = 0; a < 2; ++a)
#pragma unroll
            for (int b = 0; b < 2; ++b)
#pragma unroll
                for (int m = 0; m < 4; ++m)
#pragma unroll
                    for (int n = 0; n < 2; ++n) acc[a][b][m][n] = (f32x4){0.f, 0.f, 0.f, 0.f};
        cur = nxt; cA = nA; cB = nB; ++ui;
        if constexpr (ALIGN_EPI) { if (wr == 1) PG8_BAR; }
    }
    PG8_WAIT_V(0);
    if constexpr (!ALIGN_EPI) { if (wr == 0) PG8_BAR; }
    PG8_BAR;
#undef PG8_SA
#undef PG8_SB
#undef PG8_STAGE
#undef PG8_LDA
#undef PG8_LDB
#undef PG8_MMA
#undef PG8_WAIT_V
#undef PG8_WAIT_L
#undef PG8_BAR
#undef PG8_SCHED
}

struct Frame {
    LAS unsigned char* lds;
    int tid, lane, wave, vcu, G;
    unsigned char* ws;
};
template <int OFF> __device__ __forceinline__ const float* ldarg() { const GAS float* p; asm volatile("s_load_dwordx2 %0, %1, %2\n\ts_waitcnt lgkmcnt(0)" : "=s"(p) : "s"(__builtin_amdgcn_kernarg_segment_ptr()), "n"(OFF)); return (const float*)p; }
#define ARGP(i) (ldarg<(i) * 8>())
#define ARGO() ((float*)ldarg<96>())

__device__ __forceinline__ void p0_item(const float* W, int ldw, int k0, int sc0, bf16_t* WT, int ldk, int dr0, int dk0, float scale, LAS float* scr, int lane) {
#pragma unroll 8
    for (int i = 0; i < 32; ++i) { const int kk = 2 * i + (lane >> 5); scr[kk * 33 + (lane & 31)] = W[(size_t)(k0 + kk) * ldw + sc0 + (lane & 31)] * scale; }
    LDS_WAIT(); asm volatile("" ::: "memory");
    const int c = lane & 7;
#pragma unroll
    for (int j = 0; j < 4; ++j) { const int n = (lane >> 3) + 8 * j; const LAS float* s = scr + (8 * c) * 33 + n;
        u32x4 o; o.x = cvtpk(s[0 * 33], s[1 * 33]); o.y = cvtpk(s[2 * 33], s[3 * 33]); o.z = cvtpk(s[4 * 33], s[5 * 33]); o.w = cvtpk(s[6 * 33], s[7 * 33]);
        *(GAS u32x4*)(WT + (size_t)(dr0 + n) * ldk + dk0 + k0 + 8 * c) = o; }
    LDS_WAIT(); asm volatile("" ::: "memory");
}
__device__ __forceinline__ void p0_weights(Frame& F) {
    LAS float* scr = (LAS float*)(F.lds + 40960 + F.wave * 10240);
    const int gw = F.vcu * NWAVES + F.wave, NGW = F.G * NWAVES;
    constexpr int I_IN = 16 * (NL / 32);
    constexpr int I_AB = 8 * 32;
    constexpr int I_OUT = 16 * 32;
    constexpr int NITEMS = 2 * I_IN + 4 * I_AB + 2 * I_OUT;
    bf16_t* WIN = (bf16_t*)(F.ws + WS_WIN); bf16_t* WAB = (bf16_t*)(F.ws + WS_WAB); bf16_t* WOUT = (bf16_t*)(F.ws + WS_WOUT);
    for (int it = gw; it < NITEMS; it += NGW) {
        int r = it;
        if (r < 2 * I_IN) { const int l = r / I_IN; r -= l * I_IN; const int kb = r / (NL / 32), nb = r % (NL / 32); const int n0 = nb * 32;
            p0_item(ARGP(3) + (size_t)l * D * NINR, NINR, kb * 64, n0 + (n0 >= NLA ? 8 : 0), WIN + (size_t)l * NL * D, D, n0, 0, n0 < 512 ? QSCALE : 1.f, scr, F.lane); continue; }
        r -= 2 * I_IN;
        if (r < 4 * I_AB) { const int mtx = r / I_AB; r -= mtx * I_AB; const int l = mtx >> 1, which = mtx & 1; const int kb = r / 32, nb = r % 32;
            p0_item((which ? ARGP(10) : ARGP(9)) + (size_t)l * 512 * D, D, kb * 64, nb * 32, WAB + (size_t)l * D * D, D, nb * 32, which * 512, 1.f, scr, F.lane); continue; }
        r -= 4 * I_AB;
        { const int l = r / I_OUT; r -= l * I_OUT; const int kb = r / 32, nb = r % 32;
          p0_item(ARGP(11) + (size_t)l * D * D, D, kb * 64, nb * 32, WOUT + (size_t)l * D * D, D, nb * 32, 0, 1.f, scr, F.lane); }
    }
}

template <int MODE>
__device__ __forceinline__ void norm_pass(Frame& F, const float* xin, float* xo, const float* g_post, const float* g_pre, const float* w_in_l) {
    LAS float* gwT = (LAS float*)(F.lds);
    if (MODE != 2) {
        for (int k = F.tid; k < D; k += NTHREADS) {
            const f32x4 a = *(const f32x4*)(w_in_l + (size_t)k * NINR + 4608), b = *(const f32x4*)(w_in_l + (size_t)k * NINR + 4612);
            gwT[0 * D + k] = a[0]; gwT[1 * D + k] = a[1]; gwT[2 * D + k] = a[2]; gwT[3 * D + k] = a[3];
            gwT[4 * D + k] = b[0]; gwT[5 * D + k] = b[1]; gwT[6 * D + k] = b[2]; gwT[7 * D + k] = b[3];
        }
        __syncthreads();
    }
    const bf16_t* OUT = (const bf16_t*)(F.ws + WS_PROJ) + P_OUT;
    bf16_t* HN = (bf16_t*)(F.ws + WS_HN); float* GATES = (float*)(F.ws + WS_GATES);
    int lane_ = F.lane; asm volatile("" : "+v"(lane_));
    const int gw = F.vcu * NWAVES + F.wave, NGW = F.G * NWAVES, lane = lane_;
    for (int m = gw; m < M; m += NGW) {
        f32x4 v[4];
#pragma unroll
        for (int j = 0; j < 4; ++j) v[j] = *((const f32x4*)(xin + (size_t)m * D) + lane + 64 * j);
        if (MODE >= 1) {
            f32x4 o[4]; float so = 0.f;
#pragma unroll
            for (int j = 0; j < 4; ++j) { const u32x2 w = *((const u32x2*)(OUT + (size_t)m * LDP) + lane + 64 * j); o[j] = (f32x4){bflo(w.x), bfhi(w.x), bflo(w.y), bfhi(w.y)};
                so += (o[j][0] * o[j][0] + o[j][1] * o[j][1]) + (o[j][2] * o[j][2] + o[j][3] * o[j][3]); }
            const float r1 = rsqrtf(wave_sum(so) * (1.f / D) + EPS);
#pragma unroll
            for (int j = 0; j < 4; ++j) { const f32x4 gp = *((const f32x4*)g_post + lane + 64 * j); v[j] = v[j] + o[j] * r1 * gp; *((f32x4*)(xo + (size_t)m * D) + lane + 64 * j) = v[j]; }
        }
        if (MODE != 2) {
            float s = 0.f;
#pragma unroll
            for (int j = 0; j < 4; ++j) s += (v[j][0] * v[j][0] + v[j][1] * v[j][1]) + (v[j][2] * v[j][2] + v[j][3] * v[j][3]);
            const float r = rsqrtf(wave_sum(s) * (1.f / D) + EPS);
            float ga[8] = {0.f, 0.f, 0.f, 0.f, 0.f, 0.f, 0.f, 0.f};
#pragma unroll
            for (int j = 0; j < 4; ++j) { const f32x4 gp = *((const f32x4*)g_pre + lane + 64 * j); const f32x4 hv = v[j] * r * gp;
                u32x2 w; w.x = cvtpk(hv[0], hv[1]); w.y = cvtpk(hv[2], hv[3]); *((u32x2*)(HN + (size_t)m * D) + lane + 64 * j) = w;
#pragma unroll
                for (int g = 0; g < 8; ++g) { const f32x4 wg = *((const LAS f32x4*)(gwT + g * D) + lane + 64 * j); ga[g] += (hv[0] * wg[0] + hv[1] * wg[1]) + (hv[2] * wg[2] + hv[3] * wg[3]); } }
#pragma unroll
            for (int g = 0; g < 8; ++g) ga[g] = wave_sum(ga[g]);
            if (lane == 0) { *(f32x4*)(GATES + (size_t)m * 8) = (f32x4){ga[0], ga[1], ga[2], ga[3]}; *(f32x4*)(GATES + (size_t)m * 8 + 4) = (f32x4){ga[4], ga[5], ga[6], ga[7]}; }
        }
    }
}
constexpr int AT_SLOT = 32768, AT_VOFF = 16384;
__device__ __forceinline__ void glds16(const void* gsrc, unsigned lds_dst) { unsigned keep;
    asm volatile("s_mov_b32 %0, m0\n\ts_mov_b32 m0, %2\n\ts_nop 0\n\tglobal_load_lds_dwordx4 %1, off\n\ts_mov_b32 m0, %0" : "=&s"(keep) : "v"(gsrc), "s"(lds_dst) : "memory"); }
#define AT_WAIT_BAR(N) asm volatile("s_waitcnt vmcnt(" #N ") lgkmcnt(0)\n\ts_barrier" ::: "memory")
typedef short v4i16_t __attribute__((ext_vector_type(4)));
__device__ __forceinline__ s16x4 trrd(LAS const unsigned char* p) { return __builtin_bit_cast(s16x4, __builtin_amdgcn_ds_read_tr16_b64_v4i16((LAS v4i16_t*)p)); }
__device__ __forceinline__ bf16x8 tr2(LAS const unsigned char* p) { const s16x4 a = trrd(p), b = trrd(p + 512); return (bf16x8){a[0], a[1], a[2], a[3], b[0], b[1], b[2], b[3]}; }
__device__ __forceinline__ float half_swap_max(float m) { auto rr = __builtin_amdgcn_permlane32_swap(__float_as_uint(m), __float_as_uint(m), false, false); return fmaxf(__uint_as_float(rr[0]), __uint_as_float(rr[1])); }
__device__ __forceinline__ float half_swap_add(float m) { auto rr = __builtin_amdgcn_permlane32_swap(__float_as_uint(m), __float_as_uint(m), false, false); return __uint_as_float(rr[0]) + __uint_as_float(rr[1]); }

template <int THR>
__device__ __forceinline__ void attn_unit(Frame& F, int l, int b, int h, int qb) {
    int lane_ = F.lane; asm volatile("" : "+v"(lane_));
    const int lane = lane_, r32 = lane & 31, hi = lane >> 5, wid = F.wave, c = wid >> 2, wq = wid & 3;
    bf16_t* PROJ = (bf16_t*)(F.ws + WS_PROJ);
    const size_t rowbase = (size_t)b * SEQ;
    const int q0 = qb * 128, NT = 2 * (qb + 1);
    const unsigned lds0 = (unsigned)(uintptr_t)F.lds;
    const bf16_t* Kg = PROJ + (rowbase + lane) * LDP + P_KA + h * 128;
    const bf16_t* Vg = PROJ + (rowbase + (lane >> 2) + 16 * (wid & 3)) * LDP + P_VA + h * 128 + (lane & 3) * 8 + (wid >> 2) * 32;
#define AT_DMA(t, slot) do { const size_t to_ = (size_t)(t) * 64 * LDP; const unsigned sb_ = lds0 + (unsigned)(slot) * AT_SLOT; \
        glds16(Kg + to_ + wid * 8, (unsigned)__builtin_amdgcn_readfirstlane(sb_ + wid * 1024)); \
        glds16(Kg + to_ + (wid + 8) * 8, (unsigned)__builtin_amdgcn_readfirstlane(sb_ + (wid + 8) * 1024)); \
        glds16(Vg + to_, (unsigned)__builtin_amdgcn_readfirstlane(sb_ + AT_VOFF + wid * 1024)); \
        glds16(Vg + to_ + 64, (unsigned)__builtin_amdgcn_readfirstlane(sb_ + AT_VOFF + (wid + 8) * 1024)); } while (0)
    AT_DMA(NT - 1, 0); AT_DMA(NT - 2, 1);
    const bf16_t* Qw = PROJ + (rowbase + q0 + wq * 32 + r32) * LDP + P_QA + h * 128 + c * 64 + hi * 8;
    bf16x8 qr[4];
#pragma unroll
    for (int d0 = 0; d0 < 4; ++d0) qr[d0] = *(const bf16x8*)(Qw + d0 * 16);
    const float* lamq = ARGP(6) + l * 256;
    const float lam_init = 0.8f - 0.6f * expf(-0.3f * (float)l);
    const float lam = expf(wave_sum(lamq[lane] * lamq[64 + lane])) - expf(wave_sum(lamq[128 + lane] * lamq[192 + lane])) + lam_init;
    const float slope2 = exp2f(-2.f * (float)(h + 1)) * LOG2E;
    const int qpos = q0 + wq * 32 + r32;
    LAS float* wsf = (LAS float*)(F.lds + WSF_OFF) + wid * 64;
    float mref = 0.f, lsum = 0.f;
    f32x16 o[4];
#pragma unroll
    for (int d0 = 0; d0 < 4; ++d0)
#pragma unroll
        for (int r = 0; r < 16; ++r) o[d0][r] = 0.f;
    const int trb = ((lane >> 4) & 1) * 32 + (lane & 3) * 8 + (4 * hi + ((lane & 15) >> 2)) * 64;
    AT_WAIT_BAR(4);
    for (int i = 0; i < NT; ++i) {
        const int t = NT - 1 - i; const int slot = i % 3;
        if (i + 2 < NT) AT_DMA(t - 2, (i + 2) % 3);
        LAS const unsigned char* sl = F.lds + slot * AT_SLOT;
        const float u = slope2 * (float)(64 * t + 4 * hi - qpos) - mref;
        f32x16 p0, p1;
#pragma unroll
        for (int r = 0; r < 16; ++r) { p0[r] = u + slope2 * (float)((r & 3) + 8 * (r >> 2)); p1[r] = p0[r] + 32.f * slope2; }
        LAS const unsigned char* kb = sl + (8 * c + hi) * 1024 + r32 * 16;
#pragma unroll
        for (int d0 = 0; d0 < 4; ++d0) {
            const bf16x8 a0 = *(LAS const bf16x8*)(kb + d0 * 2048), a1 = *(LAS const bf16x8*)(kb + d0 * 2048 + 512);
            p0 = __builtin_amdgcn_mfma_f32_32x32x16_bf16(a0, qr[d0], p0, 0, 0, 0);
            p1 = __builtin_amdgcn_mfma_f32_32x32x16_bf16(a1, qr[d0], p1, 0, 0, 0);
            SBAR();
        }
        if (64 * t + 63 > q0 + 32 * wq) {
            const int dq = qpos - 64 * t - 4 * hi;
#pragma unroll
            for (int r = 0; r < 16; ++r) { const int kr = (r & 3) + 8 * (r >> 2); if (kr > dq) p0[r] = -INFINITY; if (kr + 32 > dq) p1[r] = -INFINITY; }
        }
        float ma = fmaxf(p0[0], p1[0]), mb = fmaxf(p0[1], p1[1]);
#pragma unroll
        for (int r = 2; r < 16; r += 2) { ma = fmaxf(ma, fmaxf(p0[r], p1[r])); mb = fmaxf(mb, fmaxf(p0[r + 1], p1[r + 1])); }
        const float rm = half_swap_max(fmaxf(ma, mb));
        if (__any(rm > (float)THR)) {
            const float dl = fmaxf(rm, 0.f); mref += dl;
#pragma unroll
            for (int r = 0; r < 16; ++r) { p0[r] -= dl; p1[r] -= dl; }
            const float f = ex2(-dl); lsum *= f;
            if (hi == 0) wsf[r32] = f;
            asm volatile("s_waitcnt lgkmcnt(0)" ::: "memory");
#pragma unroll
            for (int r = 0; r < 16; ++r) { const float fr = wsf[crow(r, hi)];
#pragma unroll
                for (int d0 = 0; d0 < 4; ++d0) o[d0][r] *= fr; }
            asm volatile("" ::: "memory");
        }
        float sa = 0.f, sb2 = 0.f;
#pragma unroll
        for (int r = 0; r < 16; ++r) { p0[r] = ex2(p0[r]); p1[r] = ex2(p1[r]); sa += p0[r]; sb2 += p1[r]; }
        lsum += sa + sb2;
        u32x4 pw[4];
        pw[0] = (u32x4){cvtpk(p0[0], p0[1]), cvtpk(p0[2], p0[3]), cvtpk(p0[4], p0[5]), cvtpk(p0[6], p0[7])};
        pw[1] = (u32x4){cvtpk(p0[8], p0[9]), cvtpk(p0[10], p0[11]), cvtpk(p0[12], p0[13]), cvtpk(p0[14], p0[15])};
        pw[2] = (u32x4){cvtpk(p1[0], p1[1]), cvtpk(p1[2], p1[3]), cvtpk(p1[4], p1[5]), cvtpk(p1[6], p1[7])};
        pw[3] = (u32x4){cvtpk(p1[8], p1[9]), cvtpk(p1[10], p1[11]), cvtpk(p1[12], p1[13]), cvtpk(p1[14], p1[15])};
        LAS const unsigned char* vb = sl + AT_VOFF + trb;
#pragma unroll
        for (int d0 = 0; d0 < 4; ++d0) {
#pragma unroll
            for (int ks = 0; ks < 4; ++ks) {
                const bf16x8 vf = tr2(vb + d0 * 4096 + ks * 1024);
                o[d0] = __builtin_amdgcn_mfma_f32_32x32x16_bf16(__builtin_bit_cast(bf16x8, pw[ks]), vf, o[d0], 0, 0, 0);
            }
            SBAR();
        }
        if (i + 2 < NT) AT_WAIT_BAR(4); else AT_WAIT_BAR(0);
    }
    int le = lane; asm volatile("" : "+v"(le));
    const int e_r32 = le & 31, e_hi = le >> 5;
    lsum = half_swap_add(lsum);
    if (e_hi == 0) wsf[32 + e_r32] = rcp(lsum);
    asm volatile("s_waitcnt lgkmcnt(0)" ::: "memory");
    LAS float* X = (LAS float*)(F.lds) + wq * 4096;
    if (c == 1) {
#pragma unroll
        for (int r = 0; r < 16; ++r) { const float rlr = wsf[32 + crow(r, e_hi)];
#pragma unroll
            for (int d0 = 0; d0 < 4; ++d0) X[(d0 * 16 + r) * 64 + le] = o[d0][r] * rlr; }
    }
    AT_WAIT_BAR(0);
    if (c == 0) {
        LAS float* ST = (LAS float*)(F.lds + 65536) + wq * 4096;
#pragma unroll
        for (int r = 0; r < 16; ++r) { float ss = 0.f; const float rlr = wsf[32 + crow(r, e_hi)];
#pragma unroll
            for (int d0 = 0; d0 < 4; ++d0) { const float v = o[d0][r] * rlr - lam * X[(d0 * 16 + r) * 64 + le]; o[d0][r] = v; ss += v * v; }
            ss += __shfl_xor(ss, 1); ss += __shfl_xor(ss, 2); ss += __shfl_xor(ss, 4); ss += __shfl_xor(ss, 8); ss += __shfl_xor(ss, 16);
            const float rs = rsqrtf(ss * (1.f / 128.f) + EPS) * (1.f - lam_init);
#pragma unroll
            for (int d0 = 0; d0 < 4; ++d0) ST[crow(r, e_hi) * 128 + d0 * 32 + e_r32] = o[d0][r] * rs; }
        asm volatile("s_waitcnt lgkmcnt(0)" ::: "memory");
        const int ch = le & 15;
        const float* na = ARGP(7) + l * 512 + h * 128 + ch * 8;
        const f32x4 g0 = *(const f32x4*)na, g1 = *(const f32x4*)(na + 4);
        bf16_t* pr0 = PROJ + (rowbase + q0 + wq * 32 + (le >> 4)) * LDP + h * 128 + ch * 8;
#pragma unroll 2
        for (int ps = 0; ps < 8; ++ps) {
            const int row = ps * 4 + (le >> 4);
            const f32x4 v0 = *(LAS const f32x4*)(ST + row * 128 + ch * 8), v1 = *(LAS const f32x4*)(ST + row * 128 + ch * 8 + 4);
            bf16_t* pr = pr0 + (size_t)ps * 4 * LDP;
            const u32x4 z = *(const u32x4*)(pr + P_ZA);
            u32x4 w;
            w.x = cvtpk(v0[0] * g0[0] * silu(bflo(z.x)), v0[1] * g0[1] * silu(bfhi(z.x)));
            w.y = cvtpk(v0[2] * g0[2] * silu(bflo(z.y)), v0[3] * g0[3] * silu(bfhi(z.y)));
            w.z = cvtpk(v1[0] * g1[0] * silu(bflo(z.z)), v1[1] * g1[1] * silu(bfhi(z.z)));
            w.w = cvtpk(v1[2] * g1[2] * silu(bflo(z.w)), v1[3] * g1[3] * silu(bfhi(z.w)));
            *(u32x4*)(pr + P_YA) = w;
        }
    }
    AT_WAIT_BAR(0);
#undef AT_DMA
}

__device__ __forceinline__ float logsig(float x) { return fminf(x, 0.f) - log1pf(expf(-fabsf(x))); }
__device__ __forceinline__ float wave_prefix_sum(float v, int lane) {
#pragma unroll
    for (int o = 1; o < 64; o <<= 1) { const float t = __shfl_up(v, o); if (lane >= o) v += t; }
    return v;
}
__device__ __forceinline__ float wave_prefix_max(float v, int lane) {
#pragma unroll
    for (int o = 1; o < 64; o <<= 1) { const float t = __shfl_up(v, o); if (lane >= o) v = fmaxf(v, t); }
    return v;
}
__device__ __forceinline__ float wave_max(float v) {
#pragma unroll
    for (int o = 1; o < 64; o <<= 1) v = fmaxf(v, __shfl_xor(v, o));
    return v;
}
__device__ __forceinline__ void conv8(const bf16_t* PROJ, long row0, bool first, int pcol, const float* cw, int cp, int rg, float (&y)[8][2]) {
    float x[11][2];
#pragma unroll
    for (int i = 0; i < 11; ++i) { const int rr = 8 * rg + i - 3;
        unsigned w = 0u; if (!(first && rr < 0)) w = *(const unsigned*)(PROJ + (row0 + rr) * LDP + pcol + 2 * cp);
        x[i][0] = bflo(w); x[i][1] = bfhi(w); }
    float wt[4][2];
#pragma unroll
    for (int k = 0; k < 4; ++k) { const f32x2 t = *(const f32x2*)(cw + k * 1024 + 2 * cp); wt[k][0] = t[0]; wt[k][1] = t[1]; }
#pragma unroll
    for (int r = 0; r < 8; ++r)
#pragma unroll
        for (int e = 0; e < 2; ++e) { float a = wt[0][e] * x[r][e]; a += wt[1][e] * x[r + 1][e]; a += wt[2][e] * x[r + 2][e]; a += wt[3][e] * x[r + 3][e]; y[r][e] = silu(a); }
}

__device__ __forceinline__ void mlstm1_item(Frame& F, int l, int item) {
    int tid_ = F.tid; asm volatile("" : "+v"(tid_));
    const int tid = tid_, lane = tid & 63, hi = lane >> 5, r32 = lane & 31, wave = F.wave;
    const int bh = item >> 6, ch = item & 63, b = bh >> 2, h = bh & 3; const long row0 = (long)b * SEQ + ch * 64;
    const bf16_t* PROJ = (const bf16_t*)(F.ws + WS_PROJ);
    LAS unsigned char* KW = F.lds; LAS unsigned char* VT = F.lds + 16384; LAS unsigned char* STG = F.lds + 32768; LAS float* wk = (LAS float*)(F.lds + 65536);
    const float* GATES = (const float*)(F.ws + WS_GATES); float* MSC = (float*)(F.ws + WS_MSC);
    if (wave == 0) {
        const float ig = GATES[(row0 + lane) * 8 + h] + ARGP(4)[l * 8 + h], fg = GATES[(row0 + lane) * 8 + 4 + h] + ARGP(4)[l * 8 + 4 + h];
        const float bs = wave_prefix_sum(logsig(fg), lane), bL = __shfl(bs, 63);
        const float a = bL - bs + ig, ml = wave_max(a);
        wk[lane] = expf(a - ml) * KSCALE;
        if (lane == 0) { MSC[item] = bL; MSC[1024 + item] = ml; }
    }
    u32x4 vreg[2];
#pragma unroll
    for (int ps = 0; ps < 2; ++ps) { const int row = (tid >> 4) + 32 * ps, chk = tid & 15; vreg[ps] = *(const u32x4*)(PROJ + (row0 + row) * LDP + P_VB + h * 128 + chk * 8); }
    const int cp = tid & 63, rg = tid >> 6;
    float y[8][2];
    conv8(PROJ, row0, ch == 0, P_KB + h * 128, ARGP(5) + (size_t)l * 4096 + 512 + h * 128, cp, rg, y);
    WG_BAR();
#pragma unroll
    for (int r = 0; r < 8; ++r) { const int s = 8 * rg + r, d = 2 * cp; const float w = wk[s];
        *(LAS unsigned*)(KW + (d >> 5) * 4096 + (s >> 4) * 1024 + (s & 15) * 64 + (d & 31) * 2) = cvtpk(y[r][0] * w, y[r][1] * w); }
#pragma unroll
    for (int ps = 0; ps < 2; ++ps) { const int row = (tid >> 4) + 32 * ps, chk = tid & 15;
        *(LAS u32x4*)(VT + (chk >> 2) * 4096 + (row >> 4) * 1024 + (row & 15) * 64 + (chk & 3) * 16) = vreg[ps]; }
    WG_BAR();
    if (tid < 128) { const int d = tid; float a = 0.f;
#pragma unroll 8
        for (int s = 0; s < 64; ++s) a += bf1(*(LAS const bf16_t*)(KW + (d >> 5) * 4096 + (s >> 4) * 1024 + (s & 15) * 64 + (d & 31) * 2));
        ((float*)(F.ws + WS_DN))[(size_t)item * 128 + d] = a; }
    const int db = wave >> 1, eb0 = 2 * (wave & 1);
    const int trb = ((lane >> 4) & 1) * 32 + (lane & 3) * 8 + (4 * hi + ((lane & 15) >> 2)) * 64;
    f32x16 acc[2];
#pragma unroll
    for (int r = 0; r < 16; ++r) { acc[0][r] = 0.f; acc[1][r] = 0.f; }
#pragma unroll
    for (int ks = 0; ks < 4; ++ks) {
        const bf16x8 a = tr2(KW + db * 4096 + ks * 1024 + trb);
        const bf16x8 b0 = tr2(VT + eb0 * 4096 + ks * 1024 + trb), b1 = tr2(VT + (eb0 + 1) * 4096 + ks * 1024 + trb);
        acc[0] = __builtin_amdgcn_mfma_f32_32x32x16_bf16(a, b0, acc[0], 0, 0, 0);
        acc[1] = __builtin_amdgcn_mfma_f32_32x32x16_bf16(a, b1, acc[1], 0, 0, 0);
    }
#pragma unroll
    for (int i = 0; i < 2; ++i)
#pragma unroll
        for (int r = 0; r < 16; ++r) { const int d = 32 * db + crow(r, hi), e = 32 * (eb0 + i) + r32;
            *(LAS bf16_t*)(STG + d * 256 + e * 2) = (bf16_t)(cvtpk(acc[i][r], 0.f) & 0xffffu); }
    WG_BAR();
    bf16_t* CST = (bf16_t*)(F.ws + WS_CST) + (size_t)item * 16384;
#pragma unroll
    for (int j = 0; j < 4; ++j) { const int idx = tid + 512 * j; *(u32x4*)(CST + idx * 8) = *(LAS const u32x4*)(STG + idx * 16); }
    WG_BAR();
}

__device__ __forceinline__ void mlstm_scan(Frame& F) {
    int tid_ = F.tid; asm volatile("" : "+v"(tid_));
    const int bh = F.vcu >> 4, part = F.vcu & 15, tid = tid_;
    if (bh >= 16) return;
    const float* MSC = (const float*)(F.ws + WS_MSC); float* MST = (float*)(F.ws + WS_MSC) + 2048;
    unsigned* base = (unsigned*)(F.ws + WS_CST) + (size_t)bh * 64 * 8192 + part * 512 + tid;
    float* DN = (float*)(F.ws + WS_DN) + (size_t)bh * 64 * 128;
    float m = 0.f, c0 = 0.f, c1 = 0.f, nn = 0.f;
    const bool nown = (part == 0 && tid < 128);
    if (part == 0 && tid == 0) MST[bh * 64] = 0.f;
    for (int j0 = 0; j0 < 63; j0 += 9) {
        unsigned d[9]; float dn[9];
#pragma unroll
        for (int k = 0; k < 9; ++k) { d[k] = base[(size_t)(j0 + k) * 8192]; dn[k] = nown ? DN[(j0 + k) * 128 + tid] : 0.f; }
#pragma unroll
        for (int k = 0; k < 9; ++k) { const int j = j0 + k;
            const float bL = MSC[bh * 64 + j], ml = MSC[1024 + bh * 64 + j];
            const float mn = fmaxf(bL + m, ml), f = expf(bL + m - mn), g = expf(ml - mn);
            c0 = f * c0 + g * bflo(d[k]); c1 = f * c1 + g * bfhi(d[k]);
            base[(size_t)j * 8192] = cvtpk(c0, c1);
            if (nown) { nn = f * nn + g * dn[k]; DN[j * 128 + tid] = nn; }
            m = mn;
            if (part == 0 && tid == 0) MST[bh * 64 + j + 1] = mn;
        }
    }
}

__device__ __forceinline__ void mlstm3_item(Frame& F, int l, int item) {
    int tid_ = F.tid; asm volatile("" : "+v"(tid_));
    const int tid = tid_, lane = tid & 63, hi = lane >> 5, r32 = lane & 31, wave = F.wave;
    const int bh = item >> 6, ch = item & 63, b = bh >> 2, h = bh & 3; const long row0 = (long)b * SEQ + ch * 64;
    bf16_t* PROJ = (bf16_t*)(F.ws + WS_PROJ);
    LAS unsigned char* QT = F.lds; LAS unsigned char* KT = F.lds + 16384; LAS unsigned char* VT = F.lds + 32768; LAS unsigned char* CT = F.lds + 49152;
    LAS float* ST = (LAS float*)(F.lds + 81920);
    LAS float* SC = (LAS float*)(F.lds + 114688);
    LAS float* gs = SC; LAS float* mx = SC + 64; LAS float* wint = SC + 128; LAS float* dfl = SC + 192; LAS float* qn = SC + 256; LAS float* nst = SC + 320;
    LAS float* wsf = (LAS float*)(F.lds + WSF_OFF) + wave * 64;
    const float* GATES = (const float*)(F.ws + WS_GATES); const float* MST = (const float*)(F.ws + WS_MSC) + 2048;
    if (wave == 0) {
        const float mj = MST[item];
        const float ig = GATES[(row0 + lane) * 8 + h] + ARGP(4)[l * 8 + h], fg = GATES[(row0 + lane) * 8 + 4 + h] + ARGP(4)[l * 8 + 4 + h];
        const float bs = wave_prefix_sum(logsig(fg), lane);
        const float g = ig - bs, pm = wave_prefix_max(g, lane), mxv = fmaxf(mj, pm);
        gs[lane] = g; mx[lane] = mxv; wint[lane] = expf(mj - mxv); dfl[lane] = expf(-(bs + mxv));
    } else if (wave <= 2) {
        const int d = tid - 64; nst[d] = (ch > 0) ? ((const float*)(F.ws + WS_DN))[(size_t)(item - 1) * 128 + d] : 0.f;
    }
    {
        u32x4 vreg[2], creg[4];
#pragma unroll
        for (int ps = 0; ps < 2; ++ps) { const int row = (tid >> 4) + 32 * ps, chk = tid & 15; vreg[ps] = *(const u32x4*)(PROJ + (row0 + row) * LDP + P_VB + h * 128 + chk * 8); }
        if (ch > 0) { const bf16_t* CS = (const bf16_t*)(F.ws + WS_CST) + (size_t)(item - 1) * 16384;
#pragma unroll
            for (int ps = 0; ps < 4; ++ps) creg[ps] = *(const u32x4*)(CS + (tid + 512 * ps) * 8); }
        const int cp = tid & 63, rg = tid >> 6;
        float y[8][2];
        conv8(PROJ, row0, ch == 0, P_QB + h * 128, ARGP(5) + (size_t)l * 4096 + h * 128, cp, rg, y);
#pragma unroll
        for (int r = 0; r < 8; ++r) { const int s = 8 * rg + r, d = 2 * cp;
            *(LAS unsigned*)(QT + s * 256 + ((((d >> 3) ^ (s & 15))) << 4) + (d & 7) * 2) = cvtpk(y[r][0], y[r][1]); }
        conv8(PROJ, row0, ch == 0, P_KB + h * 128, ARGP(5) + (size_t)l * 4096 + 512 + h * 128, cp, rg, y);
#pragma unroll
        for (int r = 0; r < 8; ++r) { const int s = 8 * rg + r, d = 2 * cp;
            *(LAS unsigned*)(KT + s * 256 + ((((d >> 3) ^ (s & 15))) << 4) + (d & 7) * 2) = cvtpk(y[r][0], y[r][1]); }
#pragma unroll
        for (int ps = 0; ps < 2; ++ps) { const int row = (tid >> 4) + 32 * ps, chk = tid & 15;
            *(LAS u32x4*)(VT + (chk >> 2) * 4096 + (row >> 4) * 1024 + (row & 15) * 64 + (chk & 3) * 16) = vreg[ps]; }
        if (ch > 0) {
#pragma unroll
            for (int ps = 0; ps < 4; ++ps) { const int idx = tid + 512 * ps, row = idx >> 4, chk = idx & 15;
                *(LAS u32x4*)(CT + (chk >> 2) * 8192 + (row >> 4) * 1024 + (row & 15) * 64 + (chk & 3) * 16) = creg[ps]; } }
    }
    WG_BAR();
    { const int t = tid >> 3, part = tid & 7; float a = 0.f;
#pragma unroll
        for (int k = 0; k < 2; ++k) { const int chk = 2 * part + k; const u32x4 w = *(LAS const u32x4*)(QT + t * 256 + ((chk ^ (t & 15)) << 4)); const LAS float* np = nst + chk * 8;
            a += bflo(w.x) * np[0] + bfhi(w.x) * np[1] + bflo(w.y) * np[2] + bfhi(w.y) * np[3] + bflo(w.z) * np[4] + bfhi(w.z) * np[5] + bflo(w.w) * np[6] + bfhi(w.w) * np[7]; }
        a += __shfl_xor(a, 1); a += __shfl_xor(a, 2); a += __shfl_xor(a, 4);
        if (part == 0) qn[t] = a; }
    const int tb = wave & 1, eb = wave >> 1;
    const int tq = 32 * tb + r32;
    f32x16 p0, p1;
#pragma unroll
    for (int r = 0; r < 16; ++r) { p0[r] = 0.f; p1[r] = 0.f; }
#pragma unroll
    for (int d0 = 0; d0 < 8; ++d0) {
        const int chk = 2 * d0 + hi;
        const bf16x8 qf = *(LAS const bf16x8*)(QT + tq * 256 + ((chk ^ (tq & 15)) << 4));
        const bf16x8 k0 = *(LAS const bf16x8*)(KT + r32 * 256 + ((chk ^ (r32 & 15)) << 4));
        p0 = __builtin_amdgcn_mfma_f32_32x32x16_bf16(k0, qf, p0, 0, 0, 0);
        if (tb == 1) { const bf16x8 k1 = *(LAS const bf16x8*)(KT + (32 + r32) * 256 + ((chk ^ (r32 & 15)) << 4)); p1 = __builtin_amdgcn_mfma_f32_32x32x16_bf16(k1, qf, p1, 0, 0, 0); }
        if (d0 & 1) SBAR();
    }
    const float mxt = mx[tq];
    float dsum = 0.f;
#pragma unroll
    for (int r = 0; r < 16; ++r) { const int s0 = crow(r, hi);
        const float w0 = (s0 <= tq) ? ex2((gs[s0] - mxt) * LOG2E) * KSCALE : 0.f; p0[r] *= w0;
        const float w1 = (tb == 1 && s0 + 32 <= tq) ? ex2((gs[s0 + 32] - mxt) * LOG2E) * KSCALE : 0.f; p1[r] *= w1;
        dsum += p0[r] + p1[r]; }
    dsum = half_swap_add(dsum);
    u32x4 pw[4];
    pw[0] = (u32x4){cvtpk(p0[0], p0[1]), cvtpk(p0[2], p0[3]), cvtpk(p0[4], p0[5]), cvtpk(p0[6], p0[7])};
    pw[1] = (u32x4){cvtpk(p0[8], p0[9]), cvtpk(p0[10], p0[11]), cvtpk(p0[12], p0[13]), cvtpk(p0[14], p0[15])};
    pw[2] = (u32x4){cvtpk(p1[0], p1[1]), cvtpk(p1[2], p1[3]), cvtpk(p1[4], p1[5]), cvtpk(p1[6], p1[7])};
    pw[3] = (u32x4){cvtpk(p1[8], p1[9]), cvtpk(p1[10], p1[11]), cvtpk(p1[12], p1[13]), cvtpk(p1[14], p1[15])};
    const int trb = ((lane >> 4) & 1) * 32 + (lane & 3) * 8 + (4 * hi + ((lane & 15) >> 2)) * 64;
    f32x16 a1, a2;
#pragma unroll
    for (int r = 0; r < 16; ++r) { a1[r] = 0.f; a2[r] = 0.f; }
#pragma unroll
    for (int ks = 0; ks < 4; ++ks) { if (ks < 2 || tb == 1) { const bf16x8 vf = tr2(VT + eb * 4096 + ks * 1024 + trb); a1 = __builtin_amdgcn_mfma_f32_32x32x16_bf16(__builtin_bit_cast(bf16x8, pw[ks]), vf, a1, 0, 0, 0); } }
    if (ch > 0) {
#pragma unroll
        for (int d0 = 0; d0 < 8; ++d0) {
            const u32x2 qa = *(LAS const u32x2*)(QT + tq * 256 + ((((2 * d0) ^ (tq & 15))) << 4) + 8 * hi), qb = *(LAS const u32x2*)(QT + tq * 256 + ((((2 * d0 + 1) ^ (tq & 15))) << 4) + 8 * hi);
            const u32x4 qq = (u32x4){qa.x, qa.y, qb.x, qb.y};
            const bf16x8 cf = tr2(CT + eb * 8192 + d0 * 1024 + trb);
            a2 = __builtin_amdgcn_mfma_f32_32x32x16_bf16(__builtin_bit_cast(bf16x8, qq), cf, a2, 0, 0, 0);
            if (d0 & 1) SBAR();
        }
    }
    WG_BAR();
    { const float den = dsum + wint[tq] * qn[tq]; const float hd = rcp(fmaxf(fabsf(den), dfl[tq]));
      if (hi == 0) wsf[r32] = hd; }
    asm volatile("s_waitcnt lgkmcnt(0)" ::: "memory");
#pragma unroll
    for (int r = 0; r < 16; ++r) { const int tl = crow(r, hi), t = 32 * tb + tl;
        ST[t * 128 + 32 * eb + r32] = (a1[r] + wint[t] * a2[r]) * wsf[tl]; }
    WG_BAR();
    { const int t = tid >> 3, part = tid & 7;
      bf16_t* pr = PROJ + (row0 + t) * LDP + h * 128 + part * 16;
      const u32x4 ob0 = *(const u32x4*)(pr + P_OB), ob1 = *(const u32x4*)(pr + P_OB + 8), zb0 = *(const u32x4*)(pr + P_ZB), zb1 = *(const u32x4*)(pr + P_ZB + 8);
      float hv[16];
#pragma unroll
      for (int k = 0; k < 4; ++k) { const f32x4 v = *(LAS const f32x4*)(ST + t * 128 + part * 16 + 4 * k); hv[4 * k] = v[0]; hv[4 * k + 1] = v[1]; hv[4 * k + 2] = v[2]; hv[4 * k + 3] = v[3]; }
      const unsigned obw[8] = {ob0.x, ob0.y, ob0.z, ob0.w, ob1.x, ob1.y, ob1.z, ob1.w}, zbw[8] = {zb0.x, zb0.y, zb0.z, zb0.w, zb1.x, zb1.y, zb1.z, zb1.w};
      float ss = 0.f;
#pragma unroll
      for (int k = 0; k < 8; ++k) { hv[2 * k] *= sigm(bflo(obw[k])); hv[2 * k + 1] *= sigm(bfhi(obw[k])); ss += hv[2 * k] * hv[2 * k] + hv[2 * k + 1] * hv[2 * k + 1]; }
      ss += __shfl_xor(ss, 1); ss += __shfl_xor(ss, 2); ss += __shfl_xor(ss, 4);
      const float rs = rsqrtf(ss * (1.f / 128.f) + EPS);
      const float* nb = ARGP(8) + l * 512 + h * 128 + part * 16;
      unsigned ow[8];
#pragma unroll
      for (int k = 0; k < 8; ++k) ow[k] = cvtpk(hv[2 * k] * rs * nb[2 * k] * silu(bflo(zbw[k])), hv[2 * k + 1] * rs * nb[2 * k + 1] * silu(bfhi(zbw[k])));
      *(u32x4*)(pr + P_YB) = (u32x4){ow[0], ow[1], ow[2], ow[3]}; *(u32x4*)(pr + P_YB + 8) = (u32x4){ow[4], ow[5], ow[6], ow[7]}; }
    WG_BAR();
}
constexpr int NPHASES = 17;
#ifndef MK_ONLY
#define MK_ONLY -1
#endif
#define EN(k) (MK_ONLY < 0 || MK_ONLY == (k))
struct Args { const float* in[12]; float* out; unsigned char* ws; int ph_lo, ph_hi; };

__global__ void __launch_bounds__(NTHREADS, 2) fwd_kernel(Args args) {
    extern __shared__ __attribute__((aligned(16))) unsigned char lds_raw[];
    Frame F;
    F.lds = (LAS unsigned char*)lds_raw;
    F.tid = threadIdx.x; F.lane = F.tid & 63; F.wave = __builtin_amdgcn_readfirstlane(F.tid >> 6);
    F.G = gridDim.x; { const int bx = blockIdx.x; F.vcu = (F.G % 8 == 0) ? (bx % 8) * (F.G / 8) + bx / 8 : bx; }
    F.ws = args.ws;
    volatile LAS unsigned* MISC = (volatile LAS unsigned*)(F.lds + MISC_OFF);
    for (int u = F.tid; u < (LDS_BYTES - LDSCTL_OFF) / 4; u += NTHREADS) ((LAS unsigned*)(F.lds + LDSCTL_OFF))[u] = 0u;
    __syncthreads();
    const int lo = args.ph_lo, hi = args.ph_hi;
    const bool use_bar = (hi - lo) > 1;
    XcdBarrier bar; bar.bar = (unsigned*)(F.ws + WS_CTL) + CW_BAR; bar.x = 0; bar.st = nullptr;
    if (use_bar) bar = xcd_barrier_post((unsigned*)(F.ws + WS_CTL) + CW_BAR, MISC + 8);
#define RETID() do { int t_ = threadIdx.x; asm volatile("" : "+v"(t_)); F.tid = t_; F.lane = t_ & 63; } while (0)
#define IN(k) (lo <= (k) && (k) < hi)
#define SEAM(k) do { if (IN((k) + 1)) xcd_barrier(bar); } while (0)
    bf16_t* PROJ = (bf16_t*)(F.ws + WS_PROJ); bf16_t* HN = (bf16_t*)(F.ws + WS_HN);

    if (EN(0) && IN(0)) { RETID(); p0_weights(F); RETID(); norm_pass<0>(F, ARGP(0), nullptr, nullptr, ARGP(1), ARGP(3)); SEAM(0); }

    for (int l = 0; l < 2; ++l) {
        const int pb = 1 + 8 * l;
        const bf16_t* WIN = (const bf16_t*)(F.ws + WS_WIN) + (size_t)l * NL * D;
        const bf16_t* WAB = (const bf16_t*)(F.ws + WS_WAB) + (size_t)l * D * D;
        const bf16_t* WOUT = (const bf16_t*)(F.ws + WS_WOUT) + (size_t)l * D * D;
        if (EN(1) && IN(pb + 0)) { RETID();
            Gemm g{HN, WIN, M, NLA, D, D}; StaticOrder S; S.init(M, NLA, F.G, (int)blockIdx.x);
            Epi<0> E{PROJ, LDP, nullptr, nullptr};
            gemm_phase<Epi<0>, true>(F.lds, g, S, E);
            SEAM(pb + 0);
        }
        if (EN(2) && IN(pb + 1)) { RETID();
#ifndef MK_NO_ML1
            for (int i = 0; i < 4; ++i) mlstm1_item(F, l, F.vcu * 4 + i);
#endif
#ifndef MK_NO_ATT
            const int bh = F.vcu >> 4, s = F.vcu & 15;
            for (int k = 0; k < 2; ++k) attn_unit<8>(F, l, bh >> 2, bh & 3, k == 0 ? 31 - s : s);
#endif
            SEAM(pb + 1);
        }
        if (EN(3) && IN(pb + 2)) { RETID(); mlstm_scan(F); SEAM(pb + 2); }
        if (EN(4) && IN(pb + 3)) { RETID(); for (int i = 0; i < 4; ++i) mlstm3_item(F, l, F.vcu * 4 + i); SEAM(pb + 3); }
        if (EN(5) && IN(pb + 4)) { RETID();
            Gemm g{HN, WIN + (size_t)NLA * D, M, 2048, D, D}; StaticOrder S; S.init(M, 2048, F.G, (int)blockIdx.x);
            Epi<1> E{PROJ + P_SGA, LDP, nullptr, nullptr};
            gemm_phase<Epi<1>, true>(F.lds, g, S, E);
            SEAM(pb + 4);
        }
        if (EN(6) && IN(pb + 5)) { RETID();
            Gemm g{PROJ + P_YA, WAB, M, D, D, LDP}; StaticOrder S; S.init(M, D, F.G, (int)blockIdx.x);
            Epi<2> E{PROJ + P_MG, LDP, PROJ + P_SGA, PROJ + P_SGB};
            gemm_phase<Epi<2>, false>(F.lds, g, S, E);
            SEAM(pb + 5);
        }
        if (EN(7) && IN(pb + 6)) { RETID();
            Gemm g{PROJ + P_MG, WOUT, M, D, D, LDP}; StaticOrder S; S.init(M, D, F.G, (int)blockIdx.x);
            Epi<0> E{PROJ + P_OUT, LDP, nullptr, nullptr};
            gemm_phase<Epi<0>, false>(F.lds, g, S, E);
            SEAM(pb + 6);
        }
        if (EN(8) && IN(pb + 7)) { RETID();
            if (l == 0) { norm_pass<1>(F, ARGP(0), ARGO(), ARGP(2), ARGP(1) + D, ARGP(3) + (size_t)D * NINR); SEAM(pb + 7); }
            else norm_pass<2>(F, ARGO(), ARGO(), ARGP(2) + D, nullptr, nullptr);
        }
    }
#undef IN
#undef SEAM
}

static int g_grid = 0;
static void launch_all(void* const* d_in, void* d_out, void* d_ws, hipStream_t stream, int n_launch_mode) {
    if (g_grid == 0) {
        int dev = 0, cus = 0;
        if (hipGetDevice(&dev) != hipSuccess || hipDeviceGetAttribute(&cus, hipDeviceAttributeMultiprocessorCount, dev) != hipSuccess) { g_grid = -1; return; }
        if (hipFuncSetAttribute((const void*)fwd_kernel, hipFuncAttributeMaxDynamicSharedMemorySize, LDS_BYTES) != hipSuccess) { g_grid = -1; return; }
        int per_cu = 0;
        if (hipOccupancyMaxActiveBlocksPerMultiprocessor(&per_cu, (const void*)fwd_kernel, NTHREADS, LDS_BYTES) != hipSuccess || per_cu < 1) { fprintf(stderr, "occupancy query: %d\n", per_cu); }
        (void)hipGetLastError();
        g_grid = cus;
        if (g_grid != 256) fprintf(stderr, "kernel_launch: grid %d != 256: unsupported\n", g_grid);
    }
    if (g_grid <= 0) return;
    (void)hipMemsetAsync((char*)d_ws + WS_CTL, 0, CTL_ZERO_BYTES, stream);
    Args a{};
    for (int i = 0; i < 12; ++i) a.in[i] = (const float*)d_in[i];
    a.out = (float*)d_out; a.ws = (unsigned char*)d_ws;
    if (n_launch_mode == 1) { a.ph_lo = 0; a.ph_hi = NPHASES; hipLaunchKernelGGL(fwd_kernel, dim3(g_grid), dim3(NTHREADS), LDS_BYTES, stream, a); }
    else for (int k = 0; k < NPHASES; ++k) { a.ph_lo = k; a.ph_hi = k + 1; hipLaunchKernelGGL(fwd_kernel, dim3(g_grid), dim3(NTHREADS), LDS_BYTES, stream, a); }
}
}
#ifndef MK_LAUNCH_MODE
#define MK_LAUNCH_MODE 1
#endif
extern "C" void kernel_launch(void* const* d_in, const int* in_sizes, int n_in, void* d_out, int out_size, void* d_ws, size_t ws_size, hipStream_t stream) {
    mk::launch_all(d_in, d_out, d_ws, stream, MK_LAUNCH_MODE);
}
```

```cpp
#include <hip/hip_runtime.h>
#include <cstdint>
#include <cstdio>
#include <cmath>
#define MK_LAUNCH_MODE 1
#define MK_REORDER
#define MK_M3_DYN
#define AT_FINE
#define M1_DN4
#define M1_SWAP
#define G1B_FAST
#define AT_ZPRE
#define AT_LAM_LATE
#define NP_GREG
#define NP_PIPE 2
#define AT_EPI2
#define M1_NOBAR1
#define HO_G3N
#define HO_M123
#define HO_G23
#define G1A_WT
#define HO_G1
#define HO_M3HIDE
#define NO_HANDOVER_FENCE
#define HO_NOACQ
#define HO_G1EARLY
#define HO_AMG
#define HO_P0
namespace mk {
#define LAS __attribute__((address_space(3)))
#define GAS __attribute__((address_space(1)))
typedef unsigned short bf16_t;
typedef short bf16x8 __attribute__((ext_vector_type(8)));
typedef short s16x4 __attribute__((ext_vector_type(4)));
typedef float f32x2 __attribute__((ext_vector_type(2)));
typedef float f32x4 __attribute__((ext_vector_type(4)));
typedef float f32x16 __attribute__((ext_vector_type(16)));
typedef unsigned u32x2 __attribute__((ext_vector_type(2)));
typedef unsigned u32x4 __attribute__((ext_vector_type(4)));
typedef __bf16 bf16x2_t __attribute__((ext_vector_type(2)));
typedef GAS unsigned gu32;

constexpr int D = 1024, SEQ = 4096, NBATCH = 4, M = NBATCH * SEQ, NINR = 6664, NL = 6656, NLA = 4608;
constexpr int LDP = 4608;
constexpr int P_QA = 0, P_KA = 512, P_VA = 1024, P_ZA = 1536, P_QB = 2048, P_KB = 2560, P_VB = 3072, P_OB = 3584, P_ZB = 4096;
#ifdef MK_REORDER
constexpr int P_YBX = 4096;
#else
constexpr int P_YBX = 512;
#endif
constexpr int P_YA = 0, P_YB = P_YBX, P_SGA = 1024, P_SGB = 2048, P_MG = 3072, P_OUT = 1024;
constexpr float EPS = 1e-6f, LOG2E = 1.4426950408889634f, QSCALE = 0.125f * 1.4426950408889634f, KSCALE = 0.08838834764831845f;
constexpr int NWAVES = 8, NTHREADS = 512;

constexpr size_t MiB = 1u << 20;
#ifdef HO_P0
constexpr size_t WS_CTL = 0, CTL_ZERO_BYTES = 65536;
#else
constexpr size_t WS_CTL = 0, CTL_ZERO_BYTES = 32768;
#endif
constexpr size_t WS_WIN = 1 * MiB;
constexpr size_t WS_WAB = 27 * MiB;
constexpr size_t WS_WOUT = 31 * MiB;
constexpr size_t WS_GATES = 35 * MiB;
constexpr size_t WS_MSC = 35 * MiB + 512 * 1024;
constexpr size_t WS_DN = 36 * MiB;
constexpr size_t WS_HN = 38 * MiB;
constexpr size_t WS_CST = 70 * MiB;
constexpr size_t WS_PROJ = 102 * MiB;
constexpr size_t WS_END = 246 * MiB;
constexpr int CW_BAR = 4096, CW_M3Q = 1024, CW_PANEL2 = 1152, CW_PANEL = 2048;

constexpr int RING_BYTES = 131072, WSF_OFF = 131072, LDSCTL_OFF = 135168, MISC_OFF = LDSCTL_OFF + 320, LDS_BYTES = 147456;

__device__ __forceinline__ unsigned cvtpk(float lo, float hi) { f32x2 v = {lo, hi}; bf16x2_t b = __builtin_convertvector(v, bf16x2_t); return __builtin_bit_cast(unsigned, b); }
__device__ __forceinline__ float bflo(unsigned u) { return __uint_as_float(u << 16); }
__device__ __forceinline__ float bfhi(unsigned u) { return __uint_as_float(u & 0xffff0000u); }
__device__ __forceinline__ float bf1(bf16_t u) { return __uint_as_float((unsigned)u << 16); }
__device__ __forceinline__ float ex2(float x) { return __builtin_amdgcn_exp2f(x); }
__device__ __forceinline__ float rcp(float x) { return __builtin_amdgcn_rcpf(x); }
__device__ __forceinline__ float sigm(float x) { return rcp(1.f + ex2(-x * LOG2E)); }
__device__ __forceinline__ float silu(float x) { return x * sigm(x); }
__device__ __forceinline__ float bperm(float v, int src_lane) { return __uint_as_float((unsigned)__builtin_amdgcn_ds_bpermute(src_lane << 2, (int)__float_as_uint(v))); }
template <int CTRL, int ROWMASK> __device__ __forceinline__ float dppa_f(float v) {
    return __uint_as_float((unsigned)__builtin_amdgcn_update_dpp(0, (int)__float_as_uint(v), CTRL, ROWMASK, 0xF, false)); }
__device__ __forceinline__ float wave_sum_dpp(float v) {
    v += dppa_f<0x111, 0xF>(v); v += dppa_f<0x112, 0xF>(v); v += dppa_f<0x114, 0xF>(v); v += dppa_f<0x118, 0xF>(v);
    v += dppa_f<0x142, 0xA>(v); v += dppa_f<0x143, 0xC>(v);
    return __uint_as_float((unsigned)__builtin_amdgcn_readlane((int)__float_as_uint(v), 63));
}
__device__ __forceinline__ float wave_sum(float v, int lane) {
#pragma unroll
    for (int o = 1; o < 64; o <<= 1) v += bperm(v, lane ^ o);
    return v;
}
__device__ __forceinline__ int crow(int r, int hi) { return (r & 3) + 8 * (r >> 2) + 4 * hi; }
#define LDS_WAIT() asm volatile("s_waitcnt lgkmcnt(0)" ::: "memory")
#define VM_WAIT() asm volatile("s_waitcnt vmcnt(0)" ::: "memory")
#define SBAR() __builtin_amdgcn_sched_barrier(0)
#define WG_BAR() do { asm volatile("s_waitcnt vmcnt(0) lgkmcnt(0)\n\ts_barrier" ::: "memory"); } while (0)

#define XB_TMO      128
#define XB_XCNT(j)  (256  + 64 * (j))
#define XB_XSUB(j)  (1280 + 64 * (j))
#define XB_XGEN(j)  (2304 + 64 * (j))
#define XB_TOP      3328
#define XB_TOPGEN   3392
#define XCD_BAR_WORDS 3456
#define XB_SPIN_CAP (1u << 18)
__device__ __forceinline__ unsigned xb_ld(unsigned* p)              { return __hip_atomic_load(p, __ATOMIC_RELAXED, __HIP_MEMORY_SCOPE_AGENT); }
__device__ __forceinline__ unsigned xb_add(unsigned* p, unsigned v) { return __hip_atomic_fetch_add(p, v, __ATOMIC_RELAXED, __HIP_MEMORY_SCOPE_AGENT); }
__device__ __forceinline__ unsigned xb_xcc_id() { return (unsigned)__builtin_amdgcn_s_getreg((3 << 11) | 20) & 0xFu; }
#define XB_SPIN(cond, bar) do { unsigned _sp = 0; while (cond) { __builtin_amdgcn_s_sleep(1); \
    if ((++_sp & 255u) == 0u) { if (xb_ld(&(bar)[XB_TMO])) break; if (_sp > XB_SPIN_CAP) { atomicAdd(&(bar)[XB_TMO], 1u); break; } } } } while (0)
#define XB_SPIN4(ptr, val, bar) do { unsigned* p_ = (ptr); const unsigned v_ = (val); unsigned s0_ = xb_ld(p_), s1_ = xb_ld(p_), s2_ = xb_ld(p_), s3_ = xb_ld(p_), _sp = 0; \
    for (;;) { if (s0_ != v_) break; s0_ = xb_ld(p_); if (s1_ != v_) break; s1_ = xb_ld(p_); if (s2_ != v_) break; s2_ = xb_ld(p_); if (s3_ != v_) break; s3_ = xb_ld(p_); \
        if ((++_sp & 63u) == 0u) { if (xb_ld(&(bar)[XB_TMO])) break; if (_sp > (XB_SPIN_CAP >> 2)) { atomicAdd(&(bar)[XB_TMO], 1u); break; } } } } while (0)
struct XcdBarrier { unsigned* bar; unsigned x; volatile LAS unsigned* st; int wave; };
__device__ __forceinline__ int lane_now() { unsigned m = ~0u; asm volatile("" : "+s"(m)); return (int)__builtin_amdgcn_mbcnt_hi(m, __builtin_amdgcn_mbcnt_lo(m, 0u)); }
__device__ __forceinline__ bool is_t0(int wave) { return wave == 0 && lane_now() == 0; }
__device__ __forceinline__ XcdBarrier xcd_barrier_post(unsigned* bar, volatile LAS unsigned* st, int wave) {
    XcdBarrier b; b.bar = bar; b.x = xb_xcc_id(); b.st = st; b.wave = wave;
    if (is_t0(wave)) (void)xb_add(&bar[XB_XCNT(b.x)], 1u);
    return b;
}
__device__ __forceinline__ void xcd_barrier_complete(unsigned* bar, unsigned x, unsigned& nloc, unsigned& nx) {
    const unsigned G = gridDim.x * gridDim.y * gridDim.z;
    unsigned sum, cnt, mine, sp = 0u;
    for (;;) {
        sum = 0u; cnt = 0u; mine = 0u;
#pragma unroll
        for (unsigned j = 0; j < 16; ++j) { const unsigned c = xb_ld(&bar[XB_XCNT(j)]); sum += c; cnt += (c > 0u) ? 1u : 0u; mine = (j == x) ? c : mine; }
        if (sum == G) break;
        __builtin_amdgcn_s_sleep(1);
        if ((++sp & 255u) == 0u) { if (xb_ld(&bar[XB_TMO])) break; if (sp > XB_SPIN_CAP) { atomicAdd(&bar[XB_TMO], 1u); break; } }
    }
    nloc = mine > 0u ? mine : 1u; nx = cnt > 0u ? cnt : 1u;
}
__device__ __forceinline__ void xcd_barrier(const XcdBarrier& b) {
    asm volatile("s_waitcnt vmcnt(0)" ::: "memory");
    __syncthreads();
    if (is_t0(b.wave)) {
        unsigned* bar = b.bar; unsigned bx = b.x; asm volatile("" : "+s"(bx));
        __builtin_amdgcn_s_waitcnt(0);
        unsigned nloc = b.st[0], nx = b.st[1];
        if (nloc == 0u) { xcd_barrier_complete(bar, bx, nloc, nx); b.st[0] = nloc; b.st[1] = nx; }
        const unsigned old = xb_add(&bar[XB_XSUB(bx)], 1u);
        const unsigned gen = old / nloc;
        if (old + 1u == (gen + 1u) * nloc) {
            __builtin_amdgcn_fence(__ATOMIC_RELEASE, "agent");
            asm volatile("s_waitcnt vmcnt(0)" ::: "memory");
            const unsigned og = xb_add(&bar[XB_TOP], 1u);
            const unsigned tg = og / nx;
            __builtin_amdgcn_fence(__ATOMIC_ACQUIRE, "agent");
#ifdef MK_BAR_DIRECT
            if (og + 1u == (tg + 1u) * nx) {
#pragma unroll
                for (unsigned j = 0; j < 16; ++j) (void)xb_add(&bar[XB_XGEN(j)], 1u);
            } else XB_SPIN(xb_ld(&bar[XB_XGEN(bx)]) == gen, bar);
#else
            if (og + 1u == (tg + 1u) * nx) xb_add(&bar[XB_TOPGEN], 1u);
#ifdef MK_SPIN4
            else XB_SPIN4(&bar[XB_TOPGEN], tg, bar);
#else
            else XB_SPIN(xb_ld(&bar[XB_TOPGEN]) == tg, bar);
#endif
            xb_add(&bar[XB_XGEN(bx)], 1u);
#endif
            asm volatile("s_waitcnt vmcnt(0)" ::: "memory");
        } else {
            __builtin_amdgcn_fence(__ATOMIC_ACQUIRE, "agent");
#ifdef MK_SPIN4
            XB_SPIN4(&bar[XB_XGEN(bx)], gen, bar);
            asm volatile("s_waitcnt vmcnt(3)" ::: "memory");
#else
            XB_SPIN(xb_ld(&bar[XB_XGEN(bx)]) == gen, bar);
            asm volatile("s_waitcnt vmcnt(0)" ::: "memory");
#endif
        }
    }
    __syncthreads();
}

constexpr int BM = 256, BK = 64, HALF = 128, HTB = HALF * BK * 2, NXCD = 8, WGM = 4;
__host__ __device__ __forceinline__ int lds_byte(int r, int c) { const int st = (r >> 4) * 2 + (c >> 5), rr = r & 15, cc = c & 31, ob = rr * 64 + cc * 2; return st * 1024 + (ob ^ (((ob >> 9) & 1) << 5)); }
__host__ __device__ __forceinline__ void stage_rc(int b, int& R, int& C) { const int st = b / 1024, sb = b % 1024, swz = sb ^ (((sb >> 9) & 1) << 5); R = (st >> 1) * 16 + swz / 64; C = (st & 1) * 32 + (swz % 64) / 2; }
__host__ __device__ __forceinline__ int perm32(int rho) { const int n = rho >> 4, i = rho & 15; return 8 * (i >> 2) + 4 * n + (i & 3); }
struct Unit { int pm, pn; };
struct Gemm { const bf16_t* A; const bf16_t* Bt; int M, N, K, lda; int wide = 0; int ajump = 0; };
struct StaticOrder {
    int nM, nN, nwg, G, c, max_i;
    __device__ void init(int M_, int N_, int G_, int c_) { nM = M_ / BM; nN = N_ / BM; nwg = nM * nN; G = G_; c = c_; max_i = 1 << 30; }
    __device__ bool next(int i, Unit& u) const {
        if (i >= max_i) return false;
        const long L = (long)i * G + c; if (L >= nwg) return false;
        return tile((int)L, u);
    }
    __device__ bool tile(int L, Unit& u) const {
        int wgid = L; { const int q = nwg / NXCD, r = nwg % NXCD, xcd = wgid % NXCD, off = wgid / NXCD; wgid = (xcd < r ? xcd * (q + 1) : r * (q + 1) + (xcd - r) * q) + off; }
        const int nig = WGM * nN, gid = wgid / nig, fm = gid * WGM, gsz = (nM - fm) < WGM ? (nM - fm) : WGM;
        u.pm = fm + ((wgid % nig) % gsz); u.pn = (wgid % nig) / gsz; return true;
    }
};
struct HalfOrder {
    StaticOrder base; int first;
    __device__ void init(int M_, int N_, int G_, int c_, int rounds) { base.init(M_, N_, G_, c_); first = rounds * G_; }
    __device__ bool next(int i, Unit& u) const { if (i >= 1) return false; const int L = first + (base.c >> 1); if (L >= base.nwg) return false; Unit t; base.tile(L, t); u.pm = 2 * t.pm + (base.c & 1); u.pn = t.pn; return true; }
};
struct PairedOrder {
    StaticOrder base;
    __device__ void init(int M_, int N_merge, int G_, int c_) { base.init(M_, N_merge, G_, c_); }
    __device__ bool next(int i, Unit& u) const { if (i >= 2) return false; Unit m; if (!base.next(0, m)) return false; u.pm = m.pm; u.pn = 2 * m.pn + i; return true; }
};
__device__ __forceinline__ void st16_wt(unsigned char* ws, size_t off, u32x4 v) {
    __builtin_amdgcn_raw_buffer_store_b128(v, __builtin_amdgcn_make_buffer_rsrc((void*)ws, 0, 0x7fffffff, 0x00020000), (unsigned)off, 0, 16); }
template <int MODE> struct Epi {
    static constexpr bool MID = (MODE == 2);
    bf16_t* O; int ldc; const bf16_t* GA; const bf16_t* GB;
    int nts = 0;
    int half = 0;
    int wide = 0;
    int wt = 0;
    __device__ __forceinline__ void operator()(const f32x4 (&acc)[2][2][4][2], const Unit& u, int wr, int wc, int fr_, int fq_) const {
        int fr = fr_, fq = fq_; asm volatile("" : "+v"(fr), "+v"(fq));
#ifdef MK_X_NOEPI
        { int never_ = 0; asm volatile("" : "+s"(never_)); if (!never_) return; }
#endif
#ifdef MK_X_EPILOCAL
        const int row0 = (MODE == 0 ? 0 : u.pm * (half ? HALF : BM)) + wr * 64 + fr;
#else
        const int row0 = u.pm * (half ? HALF : BM) + wr * 64 + fr;
#endif
        if (MODE == 1) {
            const int col0 = u.pn * HALF + wc * 32 + 8 * fq;
#pragma unroll
            for (int ai = 0; ai < 2; ++ai)
#pragma unroll
                for (int m = 0; m < 4; ++m) { const size_t ro = (size_t)(row0 + ai * HALF + m * 16) * ldc + col0;
                    float ra[8], sb[8];
#pragma unroll
#ifdef G1B_FAST
                    for (int j = 0; j < 4; ++j) {
                        const float db0 = 1.f + ex2(-acc[ai][1][m][0][j] * LOG2E), db1 = 1.f + ex2(-acc[ai][1][m][1][j] * LOG2E);
                        const float da0 = 1.f + ex2(-acc[ai][0][m][0][j] * LOG2E), da1 = 1.f + ex2(-acc[ai][0][m][1][j] * LOG2E);
                        sb[j] = rcp(db0); sb[4 + j] = rcp(db1); ra[j] = db0 * rcp(da0); ra[4 + j] = db1 * rcp(da1); }
#else
                    for (int j = 0; j < 4; ++j) { const float b0 = sigm(acc[ai][1][m][0][j]), b1 = sigm(acc[ai][1][m][1][j]); sb[j] = b0; sb[4 + j] = b1;
                        ra[j] = sigm(acc[ai][0][m][0][j]) * rcp(b0); ra[4 + j] = sigm(acc[ai][0][m][1][j]) * rcp(b1); }
#endif
                    *(u32x4*)(O + ro) = (u32x4){cvtpk(ra[0], ra[1]), cvtpk(ra[2], ra[3]), cvtpk(ra[4], ra[5]), cvtpk(ra[6], ra[7])};
                    *(u32x4*)((bf16_t*)GB + ro) = (u32x4){cvtpk(sb[0], sb[1]), cvtpk(sb[2], sb[3]), cvtpk(sb[4], sb[5]), cvtpk(sb[6], sb[7])}; }
            return;
        }
        const int col0 = u.pn * BM + (MODE == 0 && wide ? wc * 64 : wc * 32) + 8 * fq; const int bjs = (MODE == 0 && wide) ? 32 : HALF;
#ifdef HOOK1
        u32x4 gq[2][4][2];
        if (MODE == 2) {
#pragma unroll
            for (int ai = 0; ai < 2; ++ai)
#pragma unroll
                for (int m = 0; m < 4; ++m)
#pragma unroll
                    for (int bj = 0; bj < 2; ++bj) gq[ai][m][bj] = *(const u32x4*)(GB + (size_t)(row0 + ai * HALF + m * 16) * ldc + col0 + bj * HALF);
        }
#endif
#pragma unroll
        for (int ai = 0; ai < 2; ++ai) {
            if (ai == 1 && half) break;
            u32x4 g[4][2];
#ifdef MK_X_NOHOOK
            if (false) {
#else
            if (MODE == 2) {
#endif
#pragma unroll
                for (int m = 0; m < 4; ++m)
#pragma unroll
#ifdef HOOK1
                    for (int bj = 0; bj < 2; ++bj) g[m][bj] = gq[ai][m][bj];
#else
                    for (int bj = 0; bj < 2; ++bj) g[m][bj] = *(const u32x4*)(GB + (size_t)(row0 + ai * HALF + m * 16) * ldc + col0 + bj * HALF);
#endif
            }
#pragma unroll
            for (int m = 0; m < 4; ++m) { const size_t ro = (size_t)(row0 + ai * HALF + m * 16) * ldc + col0;
#pragma unroll
                for (int bj = 0; bj < 2; ++bj) { f32x4 v0 = acc[ai][bj][m][0], v1 = acc[ai][bj][m][1];
#ifdef MK_X_NOHOOK
                    if (false) { const u32x4 gg = g[m][bj];
#else
                    if (MODE == 2) { const u32x4 gg = g[m][bj];
#endif
                        v0[0] *= bflo(gg.x); v0[1] *= bfhi(gg.x); v0[2] *= bflo(gg.y); v0[3] *= bfhi(gg.y); v1[0] *= bflo(gg.z); v1[1] *= bfhi(gg.z); v1[2] *= bflo(gg.w); v1[3] *= bfhi(gg.w); }
                    u32x4 w; w.x = cvtpk(v0[0], v0[1]); w.y = cvtpk(v0[2], v0[3]); w.z = cvtpk(v1[0], v1[1]); w.w = cvtpk(v1[2], v1[3]);
                    if (MODE == 0 && nts) __builtin_nontemporal_store(w, (u32x4*)(O + ro + bj * bjs));
                    else if (MODE == 0 && wt) __builtin_amdgcn_raw_buffer_store_b128(w, __builtin_amdgcn_make_buffer_rsrc((void*)O, 0, 0x7fffffff, 0x00020000), (unsigned)((ro + bj * bjs) * 2), 0, 16);
                    else if (MODE == 2 && wt) __builtin_amdgcn_raw_buffer_store_b128(w, __builtin_amdgcn_make_buffer_rsrc((void*)O, 0, 0x7fffffff, 0x00020000), (unsigned)((ro + bj * HALF) * 2), 0, 16);
                    else *(u32x4*)(O + ro + bj * (MODE == 0 ? bjs : HALF)) = w; } }
            if (MODE == 2) asm volatile("" ::: "memory"); }
    }
    __device__ __forceinline__ void mid(f32x4 (&acc)[2][2][4][2], const Unit& u, int wr, int wc, int fr_, int fq_) const {
        int fr = fr_, fq = fq_; asm volatile("" : "+v"(fr), "+v"(fq));
        const int row0 = u.pm * BM + wr * 64 + fr, col0 = u.pn * BM + wc * 32 + 8 * fq;
#ifdef HOOK1
        u32x4 g[2][4][2];
#pragma unroll
        for (int ai = 0; ai < 2; ++ai)
#pragma unroll
            for (int m = 0; m < 4; ++m)
#pragma unroll
                for (int bj = 0; bj < 2; ++bj) g[ai][m][bj] = *(const u32x4*)(GA + (size_t)(row0 + ai * HALF + m * 16) * ldc + col0 + bj * HALF);
#pragma unroll
        for (int ai = 0; ai < 2; ++ai)
#pragma unroll
            for (int m = 0; m < 4; ++m)
#pragma unroll
                for (int bj = 0; bj < 2; ++bj) { const u32x4 a = g[ai][m][bj]; f32x4& v0 = acc[ai][bj][m][0]; f32x4& v1 = acc[ai][bj][m][1];
                    v0[0] *= bflo(a.x); v0[1] *= bfhi(a.x); v0[2] *= bflo(a.y); v0[3] *= bfhi(a.y); v1[0] *= bflo(a.z); v1[1] *= bfhi(a.z); v1[2] *= bflo(a.w); v1[3] *= bfhi(a.w); }
        asm volatile("" ::: "memory");
#else
#pragma unroll
        for (int ai = 0; ai < 2; ++ai) {
            u32x4 g[4][2];
#pragma unroll
            for (int m = 0; m < 4; ++m)
#pragma unroll
                for (int bj = 0; bj < 2; ++bj) g[m][bj] = *(const u32x4*)(GA + (size_t)(row0 + ai * HALF + m * 16) * ldc + col0 + bj * HALF);
#pragma unroll
            for (int m = 0; m < 4; ++m)
#pragma unroll
                for (int bj = 0; bj < 2; ++bj) { const u32x4 a = g[m][bj]; f32x4& v0 = acc[ai][bj][m][0]; f32x4& v1 = acc[ai][bj][m][1];
                    v0[0] *= bflo(a.x); v0[1] *= bfhi(a.x); v0[2] *= bflo(a.y); v0[3] *= bfhi(a.y); v1[0] *= bflo(a.z); v1[1] *= bfhi(a.z); v1[2] *= bflo(a.w); v1[3] *= bfhi(a.w); }
            asm volatile("" ::: "memory"); }
#endif
    }
};

struct NoHook { static constexpr bool ON = false; __device__ __forceinline__ void operator()(int) const {} };
template <class EpiT, bool ALIGN_EPI, class OrderT, bool HALFM = false, class HookT = NoHook>
__device__ __forceinline__ void gemm_phase(LAS unsigned char* lds, const Gemm g, const OrderT& S, const EpiT& E, int wave_, const HookT& hook = HookT()) {
    int tid_ = lane_now() + 64 * wave_; asm volatile("" : "+v"(tid_));
    const int tid = tid_, wid = wave_, lane = tid & 63, wr = wid >> 2, wc = wid & 3, fr = lane & 15, fq = lane >> 4;
    const int K = g.K, nt = K / BK, lda = g.lda;
    unsigned voffA[2], voffB[2];
#pragma unroll
    for (int i = 0; i < 2; ++i) { int R, C; stage_rc(tid * 16 + i * 8192, R, C); const int Rb = (g.wide ? 2 * (R & ~31) : (R & ~31)) + perm32(R & 31);
        voffA[i] = (unsigned)(R * lda + C) * 2u; voffB[i] = (unsigned)(Rb * K + C) * 2u; }
    const size_t kstep = (size_t)(BK * 2);
    const size_t hsA = HALFM ? 0 : (size_t)HALF * lda * 2, hsB = (size_t)(g.wide ? 32 : HALF) * K * 2, tsA = HALFM ? (size_t)HALF * lda * 2 : 2 * hsA, tsB = (size_t)BM * K * 2;
    const unsigned ldsw = (unsigned)wid * 1024u;
    const int aoff = lds_byte(wr * 64 + fr, fq * 8), boff = lds_byte(wc * 32 + fr, fq * 8);
#define PG8_SA(b, h) (((b) * 2 + (h)) * HTB)
#define PG8_SB(b, h) ((4 + (b) * 2 + (h)) * HTB)
#define PG8_STAGE(bufoff, gbase, voff) do { _Pragma("unroll") for (int _i = 0; _i < 2; ++_i) \
        __builtin_amdgcn_global_load_lds((const unsigned*)((const char*)(gbase) + (voff)[_i]), (LAS unsigned*)(lds + (bufoff) + ldsw + _i * 8192), 16, 0, 0); } while (0)
#define PG8_LDA(dst, b, h) do { _Pragma("unroll") for (int m = 0; m < 4; ++m) _Pragma("unroll") for (int k = 0; k < 2; ++k) dst[m][k] = *(const LAS bf16x8*)(lds + PG8_SA(b, h) + aoff + m * 2048 + k * 1024); } while (0)
#define PG8_LDB(dst, b, h) do { _Pragma("unroll") for (int n = 0; n < 2; ++n) _Pragma("unroll") for (int k = 0; k < 2; ++k) dst[n][k] = *(const LAS bf16x8*)(lds + PG8_SB(b, h) + boff + n * 2048 + k * 1024); } while (0)
#define PG8_MMA(ai, bj, At, Bt) do { __builtin_amdgcn_s_setprio(1); _Pragma("unroll") for (int m = 0; m < 4; ++m) _Pragma("unroll") for (int n = 0; n < 2; ++n) _Pragma("unroll") for (int k = 0; k < 2; ++k) \
        acc[ai][bj][m][n] = __builtin_amdgcn_mfma_f32_16x16x32_bf16(Bt[n][k], At[m][k], acc[ai][bj][m][n], 0, 0, 0); __builtin_amdgcn_s_setprio(0); } while (0)
#define PG8_WAIT_V(n) asm volatile("s_waitcnt vmcnt(" #n ")" ::: "memory")
#define PG8_WAIT_L(n) asm volatile("s_waitcnt lgkmcnt(" #n ")" ::: "memory")
#define PG8_BAR __builtin_amdgcn_s_barrier()
#define PG8_SCHED __builtin_amdgcn_sched_barrier(0)
    Unit cur, nxt; int ui = 0;
    if (!S.next(0, cur)) return;
    f32x4 acc[2][2][4][2];
#pragma unroll
    for (int a = 0; a < 2; ++a)
#pragma unroll
        for (int b = 0; b < 2; ++b)
#pragma unroll
            for (int m = 0; m < 4; ++m)
#pragma unroll
                for (int n = 0; n < 2; ++n) acc[a][b][m][n] = (f32x4){0.f, 0.f, 0.f, 0.f};
    bf16x8 At[4][2], B0[2][2], B1[2][2];
    const char* cA = (const char*)g.A + (size_t)cur.pm * tsA; const char* cB = (const char*)g.Bt + (size_t)cur.pn * tsB;
    PG8_STAGE(PG8_SB(0, 0), cB, voffB); PG8_STAGE(PG8_SB(0, 1), cB + hsB, voffB); PG8_STAGE(PG8_SA(0, 0), cA, voffA); PG8_STAGE(PG8_SA(0, 1), cA + hsA, voffA);
    if (wr == 1) PG8_BAR;
    PG8_WAIT_V(2); PG8_BAR;
    PG8_STAGE(PG8_SB(1, 0), cB + kstep, voffB); PG8_STAGE(PG8_SA(1, 0), cA + kstep, voffA); PG8_STAGE(PG8_SB(1, 1), cB + hsB + kstep, voffB);
    PG8_WAIT_V(6); PG8_BAR;
    for (;;) {
        const bool has_next = S.next(ui + 1, nxt);
        const char* nA = has_next ? (const char*)g.A + (size_t)nxt.pm * tsA : cA; const char* nB = has_next ? (const char*)g.Bt + (size_t)nxt.pn * tsB : cB;
        for (int t = 0; t < nt; t += 2) {
            const bool last = (t == nt - 2);
            const size_t j1 = (t + 1 >= nt / 2) ? (size_t)g.ajump : 0, j2 = (t + 2 >= nt / 2) ? (size_t)g.ajump : 0;
            const char* a1 = cA + (size_t)(t + 1) * kstep + j1;
            const char* a2 = last ? nA : cA + (size_t)(t + 2) * kstep + j2; const char* b2 = last ? nB : cB + (size_t)(t + 2) * kstep;
            const char* a3 = a2 + kstep; const char* b3 = b2 + kstep;
#ifndef MK_X_NOHOOK
            if constexpr (EpiT::MID) { if (t == nt / 2) E.mid(acc, cur, wr, wc, fr, fq); }
#endif
            PG8_LDB(B0, 0, 0); PG8_LDB(B1, 0, 1); PG8_SCHED; PG8_LDA(At, 0, 0); PG8_STAGE(PG8_SA(1, 1), a1 + hsA, voffA);
            PG8_WAIT_V(8); PG8_WAIT_L(0); PG8_BAR; PG8_MMA(0, 0, At, B0); PG8_MMA(0, 1, At, B1); PG8_BAR; PG8_SCHED;
            if constexpr (!HALFM) PG8_LDA(At, 0, 1); PG8_STAGE(PG8_SB(0, 0), b2, voffB); PG8_STAGE(PG8_SB(0, 1), b2 + hsB, voffB); PG8_STAGE(PG8_SA(0, 0), a2, voffA);
            PG8_WAIT_V(8); PG8_WAIT_L(0); PG8_BAR; if constexpr (!HALFM) { PG8_MMA(1, 0, At, B0); PG8_MMA(1, 1, At, B1); } PG8_BAR; PG8_SCHED;
            PG8_LDB(B0, 1, 0); PG8_LDB(B1, 1, 1); PG8_SCHED; PG8_LDA(At, 1, 0); PG8_STAGE(PG8_SA(0, 1), a2 + hsA, voffA);
            PG8_WAIT_V(8); PG8_WAIT_L(0); PG8_BAR; PG8_MMA(0, 0, At, B0); PG8_MMA(0, 1, At, B1); PG8_BAR; PG8_SCHED;
            if constexpr (!HALFM) PG8_LDA(At, 1, 1); PG8_STAGE(PG8_SB(1, 0), b3, voffB); PG8_STAGE(PG8_SB(1, 1), b3 + hsB, voffB); PG8_STAGE(PG8_SA(1, 0), a3, voffA);
            PG8_WAIT_V(8); PG8_WAIT_L(0); PG8_BAR; if constexpr (!HALFM) { PG8_MMA(1, 0, At, B0); PG8_MMA(1, 1, At, B1); } PG8_BAR; PG8_SCHED;
        }
        if constexpr (ALIGN_EPI) { if (wr == 0) PG8_BAR; }
        if constexpr (HookT::ON) { static_assert(ALIGN_EPI, "hook needs aligned wave halves"); if (ui == 0) { hook(wid); PG8_BAR; } }
        E(acc, cur, wr, wc, fr, fq);
        if (!has_next) break;
#pragma unroll
        for (int a = 0; a < 2; ++a)
#pragma unroll
            for (int b = 0; b < 2; ++b)
#pragma unroll
                for (int m = 0; m < 4; ++m)
#pragma unroll
                    for (int n = 0; n < 2; ++n) acc[a][b][m][n] = (f32x4){0.f, 0.f, 0.f, 0.f};
        cur = nxt; cA = nA; cB = nB; ++ui;
        if constexpr (ALIGN_EPI) { if (wr == 1) PG8_BAR; }
    }
    PG8_WAIT_V(0);
    if constexpr (!ALIGN_EPI) { if (wr == 0) PG8_BAR; }
    PG8_BAR;
#undef PG8_SA
#undef PG8_SB
#undef PG8_STAGE
#undef PG8_LDA
#undef PG8_LDB
#undef PG8_MMA
#undef PG8_WAIT_V
#undef PG8_WAIT_L
#undef PG8_BAR
#undef PG8_SCHED
}

struct Frame {
    LAS unsigned char* lds;
    int tid, lane, wave, vcu, G;
    unsigned char* ws;
};
template <int OFF> __device__ __forceinline__ const float* ldarg() { const GAS float* p; asm volatile("s_load_dwordx2 %0, %1, %2\n\ts_waitcnt lgkmcnt(0)" : "=s"(p) : "s"(__builtin_amdgcn_kernarg_segment_ptr()), "n"(OFF)); return (const float*)p; }
#define ARGP(i) (ldarg<(i) * 8>())
#define ARGO() ((float*)ldarg<96>())

#ifdef MK_TPROBE
__device__ __forceinline__ void tstamp_k(Frame& F, int kind) {
    if (is_t0(F.wave)) { volatile LAS unsigned* MISC = (volatile LAS unsigned*)(F.lds + MISC_OFF); const unsigned long long tn = __builtin_amdgcn_s_memrealtime(); const unsigned long long tp = ((unsigned long long)MISC[17] << 32) | MISC[16];
        if (kind == MK_TPROBE || MK_TPROBE == 99) MISC[18] = __float_as_uint(__uint_as_float(MISC[18]) + (float)(tn - tp) * 0.01f); MISC[16] = (unsigned)tn; MISC[17] = (unsigned)(tn >> 32); } }
#ifdef MK_TSK_AS
#define TSK(k) tstamp_k(F, MK_TSK_AS)
#else
#define TSK(k) tstamp_k(F, k)
#endif
#else
#define TSK(k) do {} while (0)
#endif
__device__ __forceinline__ void p0_item(const float* W, int ldw, int k0, int sc0, bf16_t* WT, int ldk, int dr0, int dk0, float scale, LAS float* scr, int lane, bool wt = false) {
#ifdef P0_UNROLL
#pragma unroll P0_UNROLL
#else
#pragma unroll 8
#endif
    for (int i = 0; i < 32; ++i) { const int kk = 2 * i + (lane >> 5); scr[kk * 33 + (lane & 31)] = __builtin_nontemporal_load(&W[(size_t)(k0 + kk) * ldw + sc0 + (lane & 31)]) * scale; }
    LDS_WAIT(); asm volatile("" ::: "memory");
    const int c = lane & 7;
#pragma unroll
    for (int j = 0; j < 4; ++j) { const int n = (lane >> 3) + 8 * j; const LAS float* s = scr + (8 * c) * 33 + n;
        u32x4 o; o.x = cvtpk(s[0 * 33], s[1 * 33]); o.y = cvtpk(s[2 * 33], s[3 * 33]); o.z = cvtpk(s[4 * 33], s[5 * 33]); o.w = cvtpk(s[6 * 33], s[7 * 33]);
        if (wt) __builtin_amdgcn_raw_buffer_store_b128(o, __builtin_amdgcn_make_buffer_rsrc((void*)WT, 0, 0x7fffffff, 0x00020000), (unsigned)(((size_t)(dr0 + n) * ldk + dk0 + k0 + 8 * c) * 2), 0, 16);
        else *(GAS u32x4*)(WT + (size_t)(dr0 + n) * ldk + dk0 + k0 + 8 * c) = o; }
    LDS_WAIT(); asm volatile("" ::: "memory");
}
#ifdef P0_PIPE
struct P0D { const float* src; bf16_t* dst; int ldw, ldk; float scale; };
__device__ __forceinline__ P0D p0_desc(Frame& F, int it) {
    constexpr int I_IN = 16 * (NL / 32), I_AB = 8 * 32, I_OUT = 16 * 32;
    bf16_t* WIN = (bf16_t*)(F.ws + WS_WIN); bf16_t* WAB = (bf16_t*)(F.ws + WS_WAB); bf16_t* WOUT = (bf16_t*)(F.ws + WS_WOUT);
    P0D d; int r = it;
    if (r < 2 * I_IN) { const int l = r / I_IN; r -= l * I_IN; const int kb = r / (NL / 32), nb = r % (NL / 32); const int n0 = nb * 32;
        int dr = n0;
        if (n0 >= NLA) { const int g = n0 - NLA, isb = g >= 1024 ? 1 : 0, gc = g - 1024 * isb; dr = NLA + 256 * (gc >> 7) + 128 * isb + (gc & 127); }
        d.src = ARGP(3) + (size_t)l * D * NINR + (size_t)(kb * 64) * NINR + n0 + (n0 >= NLA ? 8 : 0); d.ldw = NINR;
        d.dst = WIN + (size_t)l * NL * D + (size_t)dr * D + kb * 64; d.ldk = D; d.scale = n0 < 512 ? QSCALE : 1.f; return d; }
    r -= 2 * I_IN;
    if (r < 4 * I_AB) { const int mtx = r / I_AB; r -= mtx * I_AB; const int l = mtx >> 1, which = mtx & 1; const int kb = r / 32, nb = r % 32;
        d.src = (which ? ARGP(10) : ARGP(9)) + (size_t)l * 512 * D + (size_t)(kb * 64) * D + nb * 32; d.ldw = D;
        d.dst = WAB + (size_t)l * D * D + (size_t)(nb * 32) * D + which * 512 + kb * 64; d.ldk = D; d.scale = 1.f; return d; }
    r -= 4 * I_AB;
    { const int l = r / I_OUT; r -= l * I_OUT; const int kb = r / 32, nb = r % 32;
      d.src = ARGP(11) + (size_t)l * D * D + (size_t)(kb * 64) * D + nb * 32; d.ldw = D;
      d.dst = WOUT + (size_t)l * D * D + (size_t)(nb * 32) * D + kb * 64; d.ldk = D; d.scale = 1.f; return d; }
}
__device__ __forceinline__ void p0_weights(Frame& F) {
    LAS float* scr = (LAS float*)(F.lds + 40960 + F.wave * 10240);
    const int gw = F.vcu * NWAVES + F.wave, NGW = F.G * NWAVES, lane = F.lane;
    constexpr int NITEMS = 2 * 16 * (NL / 32) + 4 * 8 * 32 + 2 * 16 * 32;
    float xa[32], xb[32];
    P0D da = p0_desc(F, gw < NITEMS ? gw : 0), db = da;
#define P0_LOAD(d, x) do { _Pragma("unroll") for (int i = 0; i < 32; ++i) x[i] = __builtin_nontemporal_load(&(d).src[(size_t)(2 * i + (lane >> 5)) * (d).ldw + (lane & 31)]); } while (0)
    if (gw < NITEMS) P0_LOAD(da, xa);
#pragma unroll 1
    for (int it = gw; it < NITEMS; it += NGW) {
        const bool more = it + NGW < NITEMS;
        if (more) { db = p0_desc(F, it + NGW); P0_LOAD(db, xb); }
#pragma unroll
        for (int i = 0; i < 32; ++i) scr[(2 * i + (lane >> 5)) * 33 + (lane & 31)] = xa[i] * da.scale;
        LDS_WAIT(); asm volatile("" ::: "memory");
        const int c = lane & 7;
#pragma unroll
        for (int j = 0; j < 4; ++j) { const int n = (lane >> 3) + 8 * j; const LAS float* s = scr + (8 * c) * 33 + n;
            u32x4 o; o.x = cvtpk(s[0 * 33], s[1 * 33]); o.y = cvtpk(s[2 * 33], s[3 * 33]); o.z = cvtpk(s[4 * 33], s[5 * 33]); o.w = cvtpk(s[6 * 33], s[7 * 33]);
            *(GAS u32x4*)(da.dst + (size_t)n * da.ldk + 8 * c) = o; }
        LDS_WAIT(); asm volatile("" ::: "memory");
        if (more) {
#pragma unroll
            for (int i = 0; i < 32; ++i) xa[i] = xb[i];
            da = db; }
    }
#undef P0_LOAD
}
#else
__device__ __forceinline__ void p0_weights(Frame& F, int lsel = -1, bool wt = false) {
    LAS float* scr = (LAS float*)(F.lds + 40960 + F.wave * 10240);
    const int gw = F.vcu * NWAVES + F.wave, NGW = F.G * NWAVES;
    constexpr int I_IN = 16 * (NL / 32);
    constexpr int I_AB = 8 * 32;
    constexpr int I_OUT = 16 * 32;
    constexpr int NITEMS = 2 * I_IN + 4 * I_AB + 2 * I_OUT;
    bf16_t* WIN = (bf16_t*)(F.ws + WS_WIN); bf16_t* WAB = (bf16_t*)(F.ws + WS_WAB); bf16_t* WOUT = (bf16_t*)(F.ws + WS_WOUT);
    for (int it = gw; it < NITEMS; it += NGW) {
        int r = it;
        if (r < 2 * I_IN) { const int l = r / I_IN; r -= l * I_IN; if (lsel >= 0 && l != lsel) continue; const int kb = r / (NL / 32), nb = r % (NL / 32); const int n0 = nb * 32;
            int dr = n0;
            if (n0 >= NLA) { const int g = n0 - NLA, isb = g >= 1024 ? 1 : 0, gc = g - 1024 * isb; dr = NLA + 256 * (gc >> 7) + 128 * isb + (gc & 127); }
            p0_item(ARGP(3) + (size_t)l * D * NINR, NINR, kb * 64, n0 + (n0 >= NLA ? 8 : 0), WIN + (size_t)l * NL * D, D, dr, 0, n0 < 512 ? QSCALE : 1.f, scr, F.lane, wt); continue; }
        r -= 2 * I_IN;
        if (r < 4 * I_AB) { const int mtx = r / I_AB; r -= mtx * I_AB; const int l = mtx >> 1, which = mtx & 1; const int kb = r / 32, nb = r % 32; if (lsel >= 0 && l != lsel) continue;
            p0_item((which ? ARGP(10) : ARGP(9)) + (size_t)l * 512 * D, D, kb * 64, nb * 32, WAB + (size_t)l * D * D, D, nb * 32, which * 512, 1.f, scr, F.lane, wt); continue; }
        r -= 4 * I_AB;
        { const int l = r / I_OUT; r -= l * I_OUT; const int kb = r / 32, nb = r % 32; if (lsel >= 0 && l != lsel) continue;
          p0_item(ARGP(11) + (size_t)l * D * D, D, kb * 64, nb * 32, WOUT + (size_t)l * D * D, D, nb * 32, 0, 1.f, scr, F.lane, wt); }
    }
}

#endif

#ifdef NP_DPP
#define NP_WSUM(x) wave_sum_dpp(x)
#else
#define NP_WSUM(x) wave_sum(x, lane)
#endif
__device__ __forceinline__ void ho_wait4(Frame& F, int word0) {
    if (F.wave == 0) { const int ln = lane_now(); unsigned* pf = (unsigned*)(F.ws + WS_CTL) + word0 + (ln & 3); unsigned sp_ = 0;
        while (!__all(xb_ld(pf) != 0u)) { __builtin_amdgcn_s_sleep(1); if (++sp_ > XB_SPIN_CAP) break; }
        if (ln == 0) { __builtin_amdgcn_fence(__ATOMIC_ACQUIRE, "agent"); asm volatile("s_waitcnt vmcnt(0)" ::: "memory"); } }
    __syncthreads();
}
template <int MODE>
__device__ __forceinline__ void norm_pass(Frame& F, const float* xin, float* xo, const float* g_post, const float* g_pre, const float* w_in_l, int rbase = -1, int wait_word = -1) {
    LAS float* gwT = (LAS float*)(F.lds);
#ifndef NP_EARLY
    if (MODE != 2) {
        for (int k = F.tid; k < D; k += NTHREADS) {
            const f32x4 a = *(const f32x4*)(w_in_l + (size_t)k * NINR + 4608), b = *(const f32x4*)(w_in_l + (size_t)k * NINR + 4612);
            gwT[0 * D + k] = a[0]; gwT[1 * D + k] = a[1]; gwT[2 * D + k] = a[2]; gwT[3 * D + k] = a[3];
            gwT[4 * D + k] = b[0]; gwT[5 * D + k] = b[1]; gwT[6 * D + k] = b[2]; gwT[7 * D + k] = b[3];
        }
        if (wait_word < 0) __syncthreads();
    }
#endif
    if (wait_word >= 0) ho_wait4(F, wait_word);
    const bf16_t* OUT = (const bf16_t*)(F.ws + WS_PROJ) + P_OUT;
    bf16_t* HN = (bf16_t*)(F.ws + WS_HN); float* GATES = (float*)(F.ws + WS_GATES);
    int lane_ = F.lane; asm volatile("" : "+v"(lane_));
    const int gw = rbase >= 0 ? rbase + F.wave : F.vcu * NWAVES + F.wave, NGW = rbase >= 0 ? NWAVES : F.G * NWAVES, lane = lane_; const int MEND = rbase >= 0 ? rbase + 64 : M;
#ifdef NP_PIPE
    f32x4 vn[4]; u32x2 wn[4];
#define NP_LOAD(mm) do { _Pragma("unroll") for (int j = 0; j < 4; ++j) { vn[j] = __builtin_nontemporal_load((const f32x4*)(xin + (size_t)(mm) * D) + lane + 64 * j); \
        if (MODE >= 1) wn[j] = __builtin_nontemporal_load((const u32x2*)(OUT + (size_t)(mm) * LDP) + lane + 64 * j); } } while (0)
    if (gw < MEND) NP_LOAD(gw);
#ifdef NP_GREG
    f32x4 gpo[4], gpr[4];
#pragma unroll
    for (int j = 0; j < 4; ++j) { if (MODE >= 1) gpo[j] = *((const f32x4*)g_post + lane + 64 * j); if (MODE != 2) gpr[j] = *((const f32x4*)g_pre + lane + 64 * j); }
#endif
#ifdef NP_EARLY
    if (MODE != 2) {
        for (int k = F.tid; k < D; k += NTHREADS) {
            const f32x4 a = *(const f32x4*)(w_in_l + (size_t)k * NINR + 4608), b = *(const f32x4*)(w_in_l + (size_t)k * NINR + 4612);
            gwT[0 * D + k] = a[0]; gwT[1 * D + k] = a[1]; gwT[2 * D + k] = a[2]; gwT[3 * D + k] = a[3];
            gwT[4 * D + k] = b[0]; gwT[5 * D + k] = b[1]; gwT[6 * D + k] = b[2]; gwT[7 * D + k] = b[3];
        }
        __syncthreads();
    }
#endif
#if NP_PIPE == 3
    f32x4 vm[4]; u32x2 wm[4];
#pragma unroll
    for (int j = 0; j < 4; ++j) { vm[j] = vn[j]; if (MODE >= 1) wm[j] = wn[j]; }
    if (gw + NGW < MEND) NP_LOAD(gw + NGW);
#endif
#endif
    for (int m = gw; m < MEND; m += NGW) {
        f32x4 v[4];
#ifdef NP_NOHOIST
        int zrow = 0; asm volatile("" : "+v"(zrow));
#endif
#ifdef NP_PIPE
        u32x2 wc[4];
#pragma unroll
#if NP_PIPE == 3
        for (int j = 0; j < 4; ++j) { v[j] = vm[j]; vm[j] = vn[j]; if (MODE >= 1) { wc[j] = wm[j]; wm[j] = wn[j]; } }
        if (m + 2 * NGW < MEND) NP_LOAD(m + 2 * NGW);
#else
        for (int j = 0; j < 4; ++j) { v[j] = vn[j]; if (MODE >= 1) wc[j] = wn[j]; }
        if (m + NGW < MEND) NP_LOAD(m + NGW);
#endif
#else
#pragma unroll
        for (int j = 0; j < 4; ++j) v[j] = __builtin_nontemporal_load((const f32x4*)(xin + (size_t)m * D) + lane + 64 * j);
#endif
        if (MODE >= 1) {
            f32x4 o[4]; float so = 0.f;
#pragma unroll
#ifdef NP_PIPE
            for (int j = 0; j < 4; ++j) { const u32x2 w = wc[j]; o[j] = (f32x4){bflo(w.x), bfhi(w.x), bflo(w.y), bfhi(w.y)};
#else
            for (int j = 0; j < 4; ++j) { const u32x2 w = __builtin_nontemporal_load((const u32x2*)(OUT + (size_t)m * LDP) + lane + 64 * j); o[j] = (f32x4){bflo(w.x), bfhi(w.x), bflo(w.y), bfhi(w.y)};
#endif
                so += (o[j][0] * o[j][0] + o[j][1] * o[j][1]) + (o[j][2] * o[j][2] + o[j][3] * o[j][3]); }
            const float r1 = rsqrtf(NP_WSUM(so) * (1.f / D) + EPS);
#pragma unroll
#if defined(NP_GREG) && defined(NP_PIPE)
            for (int j = 0; j < 4; ++j) { const f32x4 gp = gpo[j]; v[j] = v[j] + o[j] * r1 * gp;
#else
            for (int j = 0; j < 4; ++j) { const f32x4 gp = *((const f32x4*)g_post + lane + 64 * j); v[j] = v[j] + o[j] * r1 * gp;
#endif
                __builtin_nontemporal_store(v[j], (f32x4*)(xo + (size_t)m * D) + lane + 64 * j); }
        }
        if (MODE != 2) {
            float s = 0.f;
#pragma unroll
            for (int j = 0; j < 4; ++j) s += (v[j][0] * v[j][0] + v[j][1] * v[j][1]) + (v[j][2] * v[j][2] + v[j][3] * v[j][3]);
            const float r = rsqrtf(NP_WSUM(s) * (1.f / D) + EPS);
            float ga[8] = {0.f, 0.f, 0.f, 0.f, 0.f, 0.f, 0.f, 0.f};
#pragma unroll
#if defined(NP_GREG) && defined(NP_PIPE)
            for (int j = 0; j < 4; ++j) { const f32x4 gp = gpr[j]; const f32x4 hv = v[j] * r * gp;
#else
            for (int j = 0; j < 4; ++j) { const f32x4 gp = *((const f32x4*)g_pre + lane + 64 * j); const f32x4 hv = v[j] * r * gp;
#endif
                u32x2 w; w.x = cvtpk(hv[0], hv[1]); w.y = cvtpk(hv[2], hv[3]);
#ifdef HO_P0
                if (MODE == 0) __hip_atomic_store((unsigned long long*)((u32x2*)(HN + (size_t)m * D) + lane + 64 * j), ((unsigned long long)w.y << 32) | w.x, __ATOMIC_RELAXED, __HIP_MEMORY_SCOPE_AGENT);
                else
#endif
                *((u32x2*)(HN + (size_t)m * D) + lane + 64 * j) = w;

#pragma unroll
#ifdef NP_NOHOIST
                for (int g = 0; g < 8; ++g) { const f32x4 wg = *((const LAS f32x4*)(gwT + g * D + zrow) + lane + 64 * j);
#else
                for (int g = 0; g < 8; ++g) { const f32x4 wg = *((const LAS f32x4*)(gwT + g * D) + lane + 64 * j);
#endif
                    ga[g] += (hv[0] * wg[0] + hv[1] * wg[1]) + (hv[2] * wg[2] + hv[3] * wg[3]); } }
#pragma unroll
            for (int g = 0; g < 8; ++g) ga[g] = NP_WSUM(ga[g]);
            if (lane == 0) {
#ifdef HO_P0
                if (MODE == 0) {
#pragma unroll
                    for (int g = 0; g < 8; ++g) __hip_atomic_store((unsigned*)(GATES + (size_t)m * 8 + g), __float_as_uint(ga[g]), __ATOMIC_RELAXED, __HIP_MEMORY_SCOPE_AGENT);
                } else
#endif
                { *(f32x4*)(GATES + (size_t)m * 8) = (f32x4){ga[0], ga[1], ga[2], ga[3]}; *(f32x4*)(GATES + (size_t)m * 8 + 4) = (f32x4){ga[4], ga[5], ga[6], ga[7]}; } }
        }
    }
}
constexpr int AT_SLOT = 32768, AT_VOFF = 16384;
__device__ __forceinline__ void glds16(const void* gsrc, unsigned lds_dst) { unsigned keep;
    asm volatile("s_mov_b32 %0, m0\n\ts_mov_b32 m0, %2\n\ts_nop 0\n\tglobal_load_lds_dwordx4 %1, off\n\ts_mov_b32 m0, %0" : "=&s"(keep) : "v"(gsrc), "s"(lds_dst) : "memory"); }
__device__ __forceinline__ void glds16s(const void* sbase_, unsigned voff, unsigned lds_dst) { unsigned keep;
    const unsigned long long b_ = (unsigned long long)sbase_; const void* sbase = (const void*)(((unsigned long long)(unsigned)__builtin_amdgcn_readfirstlane((int)(b_ >> 32)) << 32) | (unsigned)__builtin_amdgcn_readfirstlane((int)b_));
    asm volatile("s_nop 4\n\ts_mov_b32 %0, m0\n\ts_mov_b32 m0, %3\n\ts_nop 0\n\tglobal_load_lds_dwordx4 %1, %2\n\ts_mov_b32 m0, %0" : "=&s"(keep) : "v"(voff), "s"(sbase), "s"(lds_dst) : "memory"); }
#define AT_WAIT_BAR_L() asm volatile("s_waitcnt lgkmcnt(0)\n\ts_barrier" ::: "memory")
#define AT_WAIT_BAR(N) asm volatile("s_waitcnt vmcnt(" #N ") lgkmcnt(0)\n\ts_barrier" ::: "memory")
typedef short v4i16_t __attribute__((ext_vector_type(4)));
__device__ __forceinline__ s16x4 trrd(LAS const unsigned char* p) { return __builtin_bit_cast(s16x4, __builtin_amdgcn_ds_read_tr16_b64_v4i16((LAS v4i16_t*)p)); }
__device__ __forceinline__ bf16x8 tr2(LAS const unsigned char* p) { const s16x4 a = trrd(p), b = trrd(p + 512); return (bf16x8){a[0], a[1], a[2], a[3], b[0], b[1], b[2], b[3]}; }
__device__ __forceinline__ float half_swap_max(float m) { auto rr = __builtin_amdgcn_permlane32_swap(__float_as_uint(m), __float_as_uint(m), false, false); return fmaxf(__uint_as_float(rr[0]), __uint_as_float(rr[1])); }
__device__ __forceinline__ float half_swap_add(float m) { auto rr = __builtin_amdgcn_permlane32_swap(__float_as_uint(m), __float_as_uint(m), false, false); return __uint_as_float(rr[0]) + __uint_as_float(rr[1]); }

__device__ __forceinline__ float max3f(float a, float b, float c) { float r; asm("v_max3_f32 %0, %1, %2, %3" : "=v"(r) : "v"(a), "v"(b), "v"(c)); return r; }
__device__ __forceinline__ float max2f(float a, float b) { float r; asm("v_max_f32_e32 %0, %1, %2" : "=v"(r) : "v"(a), "v"(b)); return r; }
template <int THR, bool PRE = false>
__device__ __forceinline__ void attn_unit(Frame& F, int l, int b, int h, int qb) {
    int lane_ = F.lane; asm volatile("" : "+v"(lane_));
#ifdef AT_PARITY
    const int lane = lane_, r32 = lane & 31, hi = lane >> 5, wid = F.wave, c = wid & 1, wq = wid >> 1;
#else
    const int lane = lane_, r32 = lane & 31, hi = lane >> 5, wid = F.wave, c = wid >> 2, wq = wid & 3;
#endif
    bf16_t* PROJ = (bf16_t*)(F.ws + WS_PROJ);
    const size_t rowbase = (size_t)b * SEQ;
    const int q0 = qb * 128, NT = 2 * (qb + 1);
    const unsigned lds0 = (unsigned)(uintptr_t)F.lds;
    const int kr0 = 8 * wid + (lane >> 4), kr1 = kr0 + 4;
    const unsigned kof0 = (unsigned)(kr0 * LDP + P_KA + h * 128 + ((lane & 15) ^ (kr0 & 15)) * 8) * 2u;
    const unsigned kof1 = (unsigned)(kr1 * LDP + P_KA + h * 128 + ((lane & 15) ^ (kr1 & 15)) * 8) * 2u;
    const unsigned vof0 = (unsigned)(((lane >> 2) + 16 * (wid & 3)) * LDP + P_VA + h * 128 + (lane & 3) * 8 + (wid >> 2) * 32) * 2u;
    const bf16_t* KVb = PROJ + rowbase * LDP;
#define AT_DMA(t, slot) do { const bf16_t* tb_ = KVb + (size_t)(t) * 64 * LDP; const unsigned sb_ = lds0 + (unsigned)(slot) * AT_SLOT; \
        glds16s(tb_, kof0, (unsigned)__builtin_amdgcn_readfirstlane(sb_ + wid * 2048)); \
        glds16s(tb_, kof1, (unsigned)__builtin_amdgcn_readfirstlane(sb_ + wid * 2048 + 1024)); \
        glds16s(tb_, vof0, (unsigned)__builtin_amdgcn_readfirstlane(sb_ + AT_VOFF + wid * 1024)); \
        glds16s(tb_, vof0 + 128u, (unsigned)__builtin_amdgcn_readfirstlane(sb_ + AT_VOFF + (wid + 8) * 1024)); } while (0)
#ifdef AT_DMA_FIRST
    AT_DMA(NT - 1, 0); AT_DMA(NT - 2, 1); if (NT > 2) AT_DMA(NT - 3, 2);
#endif
    const bf16_t* Qw = PROJ + (rowbase + q0 + wq * 32 + r32) * LDP + P_QA + h * 128 + c * 64 + hi * 8;
    bf16x8 qr[4];
#pragma unroll
    for (int d0 = 0; d0 < 4; ++d0) qr[d0] = *(const bf16x8*)(Qw + d0 * 16);
    const float lam_init = 0.8f - 0.6f * expf(-0.3f * (float)l);
#ifndef AT_LAM_LATE
    const float* lamq = ARGP(6) + l * 256;
    const float lam = expf(wave_sum(lamq[lane] * lamq[64 + lane], lane)) - expf(wave_sum(lamq[128 + lane] * lamq[192 + lane], lane)) + lam_init;
#endif
#ifndef AT_DMA_FIRST
    if (!PRE) { AT_DMA(NT - 1, 0); AT_DMA(NT - 2, 1); if (NT > 2) AT_DMA(NT - 3, 2); }
#endif
    const float slope2 = exp2f(-2.f * (float)(h + 1)) * LOG2E;
    float s1 = slope2, s2 = 2.f * slope2, s3 = 3.f * slope2, s8 = 8.f * slope2, s32 = 32.f * slope2;
    asm volatile("" : "+v"(s1), "+v"(s2), "+v"(s3), "+v"(s8), "+v"(s32));
    const int qpos = q0 + wq * 32 + r32;
    LAS float* wsf = (LAS float*)(F.lds + WSF_OFF) + wid * 64;
    float mref = 0.f, lsum = 0.f;
    f32x16 o[4];
#pragma unroll
    for (int d0 = 0; d0 < 4; ++d0)
#pragma unroll
        for (int r = 0; r < 16; ++r) o[d0][r] = 0.f;
    const int trb = ((lane >> 4) & 1) * 32 + (lane & 3) * 8 + (4 * hi + ((lane & 15) >> 2)) * 64;
    int ka[4];
#pragma unroll
    for (int d0 = 0; d0 < 4; ++d0) ka[d0] = r32 * 256 + ((((8 * c + 2 * d0 + hi) ^ (r32 & 15))) << 4);
    if (NT > 2) AT_WAIT_BAR(4); else AT_WAIT_BAR(0);
    bf16x8 kf[8];
#pragma unroll
    for (int d0 = 0; d0 < 4; ++d0) { kf[2 * d0] = *(LAS const bf16x8*)(F.lds + ka[d0]); kf[2 * d0 + 1] = *(LAS const bf16x8*)(F.lds + ka[d0] + 8192); }
#ifdef AT_STAGGER
    if (c == 1) AT_WAIT_BAR_L();
#endif
#ifdef AT_CINIT
#define AT_CI(tt) do { const float u_ = slope2 * (float)(64 * (tt) + 4 * hi - qpos) - mref; \
        _Pragma("unroll") for (int g = 0; g < 4; ++g) { const float ug = u_ + s8 * (float)g; p0[4 * g] = ug; p0[4 * g + 1] = ug + s1; p0[4 * g + 2] = ug + s2; p0[4 * g + 3] = ug + s3; } \
        _Pragma("unroll") for (int r = 0; r < 16; ++r) p1[r] = p0[r] + s32; } while (0)
    f32x16 p0, p1;
    AT_CI(NT - 1);
#endif
    for (int i = 0; i < NT; ++i) {
        const int t = NT - 1 - i; const int slot = i & 3;
#if !defined(AT_STAGGER) && !defined(AT_X_NODMA)
        if (i + 3 < NT) AT_DMA(t - 3, (i + 3) & 3);
#endif
        LAS const unsigned char* sl = F.lds + slot * AT_SLOT;
        LAS const unsigned char* vb = sl + AT_VOFF + trb;
#ifndef AT_CINIT
        const float u = slope2 * (float)(64 * t + 4 * hi - qpos) - mref;
        f32x16 p0, p1;
#pragma unroll
        for (int g = 0; g < 4; ++g) { const float ug = u + s8 * (float)g;
            p0[4 * g] = ug; p0[4 * g + 1] = ug + s1; p0[4 * g + 2] = ug + s2; p0[4 * g + 3] = ug + s3; }
#pragma unroll
        for (int r = 0; r < 16; ++r) p1[r] = p0[r] + s32;
#endif
#pragma unroll
#ifndef AT_X_NOQK
        for (int d0 = 0; d0 < 4; ++d0) {
            p0 = __builtin_amdgcn_mfma_f32_32x32x16_bf16(kf[2 * d0], qr[d0], p0, 0, 0, 0);
            p1 = __builtin_amdgcn_mfma_f32_32x32x16_bf16(kf[2 * d0 + 1], qr[d0], p1, 0, 0, 0);
        }
#else
        for (int d0 = 0; d0 < 4; ++d0) { p0[d0] += __uint_as_float((unsigned)kf[2 * d0][0]); p1[d0] += __uint_as_float((unsigned)kf[2 * d0 + 1][0]); }
#endif
        bf16x8 vA[4], vB[4];
#pragma unroll
#ifdef AT_SPLIT
        for (int ks = 0; ks < 4; ++ks) vA[ks] = tr2(vb + (ks >> 1) * 4096 + (ks & 1) * 1024);
#else
        for (int ks = 0; ks < 4; ++ks) vA[ks] = tr2(vb + 0 * 4096 + ks * 1024);
#endif
#ifdef AT_FINE1
#pragma unroll
        for (int q = 0; q < 8; ++q) { __builtin_amdgcn_sched_group_barrier(0x008, 1, 0); __builtin_amdgcn_sched_group_barrier(0x100, 1, 0); }
#endif
        asm volatile("s_nop 15" : "+v"(p0), "+v"(p1));
        SBAR();
        if (64 * t + 63 > q0 + 32 * wq) {
            const int dq = qpos - 64 * t - 4 * hi;
#pragma unroll
            for (int r = 0; r < 16; ++r) { const int kr = (r & 3) + 8 * (r >> 2); if (kr > dq) p0[r] = -INFINITY; if (kr + 32 > dq) p1[r] = -INFINITY; }
        }
#ifndef AT_X_NOSM
        float ma = max3f(p0[0], p0[1], p1[0]), mb = max3f(p0[2], p0[3], p1[1]); ma = max3f(ma, p1[2], p1[3]);
#pragma unroll
        for (int r = 4; r < 16; r += 4) { ma = max3f(ma, p0[r], p0[r + 1]); mb = max3f(mb, p0[r + 2], p0[r + 3]); ma = max3f(ma, p1[r], p1[r + 1]); mb = max3f(mb, p1[r + 2], p1[r + 3]); }
        float rm = max2f(ma, mb);
        { auto rr = __builtin_amdgcn_permlane32_swap(__float_as_uint(rm), __float_as_uint(rm), false, false); rm = max2f(__uint_as_float(rr[0]), __uint_as_float(rr[1])); }
        if (__any(rm > (float)THR)) {
            const float dl = fmaxf(rm, 0.f); mref += dl;
#pragma unroll
            for (int r = 0; r < 16; ++r) { p0[r] -= dl; p1[r] -= dl; }
            const float f = ex2(-dl); lsum *= f;
            if (hi == 0) wsf[r32] = f;
            asm volatile("s_waitcnt lgkmcnt(0)" ::: "memory");
#pragma unroll
            for (int r = 0; r < 16; ++r) { const float fr = wsf[crow(r, hi)];
#pragma unroll
                for (int d0 = 0; d0 < 4; ++d0) o[d0][r] *= fr; }
            asm volatile("" ::: "memory");
        }
#ifndef AT_SPLIT
        float sa = 0.f, sb2 = 0.f;
#pragma unroll
        for (int r = 0; r < 16; ++r) { p0[r] = ex2(p0[r]); p1[r] = ex2(p1[r]); sa += p0[r]; sb2 += p1[r]; }
        lsum += sa + sb2;
#endif
#ifdef AT_SPLIT
        float sa = 0.f, sb2 = 0.f;
#pragma unroll
        for (int r = 0; r < 16; ++r) { p0[r] = ex2(p0[r]); sa += p0[r]; }
        u32x4 pw[4];
        pw[0] = (u32x4){cvtpk(p0[0], p0[1]), cvtpk(p0[2], p0[3]), cvtpk(p0[4], p0[5]), cvtpk(p0[6], p0[7])};
        pw[1] = (u32x4){cvtpk(p0[8], p0[9]), cvtpk(p0[10], p0[11]), cvtpk(p0[12], p0[13]), cvtpk(p0[14], p0[15])};
        SBAR();
        {
        LAS const unsigned char* sn = F.lds + ((i + 1) & 3) * AT_SLOT;
#define AT_V(d, k) tr2(vb + (d) * 4096 + (k) * 1024)
#define AT_PV(d, k, vf) o[d] = __builtin_amdgcn_mfma_f32_32x32x16_bf16(__builtin_bit_cast(bf16x8, pw[k]), vf, o[d], 0, 0, 0)
        bf16x8 vE[4], vF[4], vG[4];
        AT_PV(0, 0, vA[0]); vE[0] = AT_V(2, 0);
        AT_PV(0, 1, vA[1]); vE[1] = AT_V(2, 1);
        AT_PV(1, 0, vA[2]); vE[2] = AT_V(3, 0);
        AT_PV(1, 1, vA[3]); vE[3] = AT_V(3, 1);
        AT_PV(2, 0, vE[0]); vF[0] = AT_V(0, 2);
        AT_PV(2, 1, vE[1]); vF[1] = AT_V(0, 3);
        AT_PV(3, 0, vE[2]); vF[2] = AT_V(1, 2);
        AT_PV(3, 1, vE[3]); vF[3] = AT_V(1, 3);
#pragma unroll
        for (int r = 0; r < 16; ++r) { p1[r] = ex2(p1[r]); sb2 += p1[r]; }
        pw[2] = (u32x4){cvtpk(p1[0], p1[1]), cvtpk(p1[2], p1[3]), cvtpk(p1[4], p1[5]), cvtpk(p1[6], p1[7])};
        pw[3] = (u32x4){cvtpk(p1[8], p1[9]), cvtpk(p1[10], p1[11]), cvtpk(p1[12], p1[13]), cvtpk(p1[14], p1[15])};
        lsum += sa + sb2;
#pragma unroll
        for (int q = 0; q < 8; ++q) { __builtin_amdgcn_sched_group_barrier(0x008, 1, 0); __builtin_amdgcn_sched_group_barrier(0x100, 2, 0); __builtin_amdgcn_sched_group_barrier(0x400, 2, 0); __builtin_amdgcn_sched_group_barrier(0x002, AT_SPLIT, 0); }
        SBAR();
        AT_PV(0, 2, vF[0]); vG[0] = AT_V(2, 2);
        AT_PV(0, 3, vF[1]); vG[1] = AT_V(2, 3);
        AT_PV(1, 2, vF[2]); vG[2] = AT_V(3, 2);
        AT_PV(1, 3, vF[3]); vG[3] = AT_V(3, 3);
        AT_PV(2, 2, vG[0]); kf[0] = *(LAS const bf16x8*)(sn + ka[0]); kf[1] = *(LAS const bf16x8*)(sn + ka[0] + 8192);
        AT_PV(2, 3, vG[1]); kf[2] = *(LAS const bf16x8*)(sn + ka[1]); kf[3] = *(LAS const bf16x8*)(sn + ka[1] + 8192);
        AT_PV(3, 2, vG[2]); kf[4] = *(LAS const bf16x8*)(sn + ka[2]); kf[5] = *(LAS const bf16x8*)(sn + ka[2] + 8192);
        AT_PV(3, 3, vG[3]); kf[6] = *(LAS const bf16x8*)(sn + ka[3]); kf[7] = *(LAS const bf16x8*)(sn + ka[3] + 8192);
#pragma unroll
        for (int q = 0; q < 8; ++q) { __builtin_amdgcn_sched_group_barrier(0x008, 1, 0); __builtin_amdgcn_sched_group_barrier(0x100, 2, 0); }
        SBAR();
#undef AT_V
#undef AT_PV
        }
#endif
#else
        lsum += p0[0];
#endif
#ifndef AT_SPLIT
        u32x4 pw[4];
        pw[0] = (u32x4){cvtpk(p0[0], p0[1]), cvtpk(p0[2], p0[3]), cvtpk(p0[4], p0[5]), cvtpk(p0[6], p0[7])};
        pw[1] = (u32x4){cvtpk(p0[8], p0[9]), cvtpk(p0[10], p0[11]), cvtpk(p0[12], p0[13]), cvtpk(p0[14], p0[15])};
        pw[2] = (u32x4){cvtpk(p1[0], p1[1]), cvtpk(p1[2], p1[3]), cvtpk(p1[4], p1[5]), cvtpk(p1[6], p1[7])};
        pw[3] = (u32x4){cvtpk(p1[8], p1[9]), cvtpk(p1[10], p1[11]), cvtpk(p1[12], p1[13]), cvtpk(p1[14], p1[15])};
        SBAR();
#ifdef AT_STAGGER
        AT_WAIT_BAR_L();
        if (i + 3 < NT) AT_DMA(t - 3, (i + 3) & 3);
#endif
#ifndef AT_X_NOPV
#ifdef AT_FINE
        LAS const unsigned char* sn = F.lds + ((i + 1) & 3) * AT_SLOT;
        bf16x8 vC[4], vD[4];
#pragma unroll
        for (int ks = 0; ks < 4; ++ks) { o[0] = __builtin_amdgcn_mfma_f32_32x32x16_bf16(__builtin_bit_cast(bf16x8, pw[ks]), vA[ks], o[0], 0, 0, 0); vB[ks] = tr2(vb + 1 * 4096 + ks * 1024); }
#pragma unroll
        for (int ks = 0; ks < 4; ++ks) { o[1] = __builtin_amdgcn_mfma_f32_32x32x16_bf16(__builtin_bit_cast(bf16x8, pw[ks]), vB[ks], o[1], 0, 0, 0); vC[ks] = tr2(vb + 2 * 4096 + ks * 1024); }
#pragma unroll
        for (int ks = 0; ks < 4; ++ks) { o[2] = __builtin_amdgcn_mfma_f32_32x32x16_bf16(__builtin_bit_cast(bf16x8, pw[ks]), vC[ks], o[2], 0, 0, 0); vD[ks] = tr2(vb + 3 * 4096 + ks * 1024); }
#pragma unroll
        for (int ks = 0; ks < 4; ++ks) { o[3] = __builtin_amdgcn_mfma_f32_32x32x16_bf16(__builtin_bit_cast(bf16x8, pw[ks]), vD[ks], o[3], 0, 0, 0);
            kf[2 * ks] = *(LAS const bf16x8*)(sn + ka[ks]); kf[2 * ks + 1] = *(LAS const bf16x8*)(sn + ka[ks] + 8192); }
#ifdef AT_CINIT
        AT_CI(t - 1);
#pragma unroll
        for (int q = 0; q < 8; ++q) { __builtin_amdgcn_sched_group_barrier(0x008, 1, 0); __builtin_amdgcn_sched_group_barrier(0x100, 2, 0); }
#pragma unroll
        for (int q = 0; q < 8; ++q) { __builtin_amdgcn_sched_group_barrier(0x008, 1, 0); __builtin_amdgcn_sched_group_barrier(0x100, 2, 0); __builtin_amdgcn_sched_group_barrier(0x002, 4, 0); }
        asm volatile("" : "+v"(p0), "+v"(p1));
#else
#pragma unroll
        for (int q = 0; q < 16; ++q) { __builtin_amdgcn_sched_group_barrier(0x008, 1, 0); __builtin_amdgcn_sched_group_barrier(0x100, 2, 0); }
#endif
        SBAR();
#else
        const bool more = (i + 1 < NT);
        LAS const unsigned char* sn = F.lds + ((i + 1) & 3) * AT_SLOT;
#pragma unroll
        for (int ks = 0; ks < 4; ++ks) vB[ks] = tr2(vb + 1 * 4096 + ks * 1024);
#pragma unroll
        for (int ks = 0; ks < 4; ++ks) o[0] = __builtin_amdgcn_mfma_f32_32x32x16_bf16(__builtin_bit_cast(bf16x8, pw[ks]), vA[ks], o[0], 0, 0, 0);
        if (more) {
#pragma unroll
            for (int d0 = 0; d0 < 2; ++d0) { kf[2 * d0] = *(LAS const bf16x8*)(sn + ka[d0]); kf[2 * d0 + 1] = *(LAS const bf16x8*)(sn + ka[d0] + 8192); } }
        SBAR();
        bf16x8 vC[4], vD[4];
#pragma unroll
        for (int ks = 0; ks < 4; ++ks) vC[ks] = tr2(vb + 2 * 4096 + ks * 1024);
#pragma unroll
        for (int ks = 0; ks < 4; ++ks) o[1] = __builtin_amdgcn_mfma_f32_32x32x16_bf16(__builtin_bit_cast(bf16x8, pw[ks]), vB[ks], o[1], 0, 0, 0);
        if (more) {
#pragma unroll
            for (int d0 = 2; d0 < 4; ++d0) { kf[2 * d0] = *(LAS const bf16x8*)(sn + ka[d0]); kf[2 * d0 + 1] = *(LAS const bf16x8*)(sn + ka[d0] + 8192); } }
        SBAR();
#pragma unroll
        for (int ks = 0; ks < 4; ++ks) vD[ks] = tr2(vb + 3 * 4096 + ks * 1024);
#pragma unroll
        for (int ks = 0; ks < 4; ++ks) o[2] = __builtin_amdgcn_mfma_f32_32x32x16_bf16(__builtin_bit_cast(bf16x8, pw[ks]), vC[ks], o[2], 0, 0, 0);
        SBAR();
#pragma unroll
        for (int ks = 0; ks < 4; ++ks) o[3] = __builtin_amdgcn_mfma_f32_32x32x16_bf16(__builtin_bit_cast(bf16x8, pw[ks]), vD[ks], o[3], 0, 0, 0);
#endif
#else
        o[0][0] += __uint_as_float(pw[0].x) + __uint_as_float(pw[1].y) + __uint_as_float(pw[2].z) + __uint_as_float(pw[3].w) + __uint_as_float((unsigned)vA[0][0]);
#endif
#endif
#if defined(AT_X_NOBAR)
        asm volatile("s_waitcnt vmcnt(0) lgkmcnt(0)" ::: "memory");
#elif defined(AT_X_NODMA)
        AT_WAIT_BAR(0);
#elif defined(AT_NOLGKM)
        if (i + 3 < NT) asm volatile("s_waitcnt vmcnt(4)\n\ts_barrier" ::: "memory"); else asm volatile("s_waitcnt vmcnt(0)\n\ts_barrier" ::: "memory");
#else
        if (i + 3 < NT) AT_WAIT_BAR(4); else AT_WAIT_BAR(0);
#endif
    }
#ifdef AT_STAGGER
    if (c == 0) AT_WAIT_BAR_L();
#endif
#ifdef AT_EPI2
    int le = lane; asm volatile("" : "+v"(le));
    const int e_r32 = le & 31, e_hi = le >> 5;
    u32x4 zr[4];
    { const bf16_t* pz = PROJ + (rowbase + q0 + wq * 32 + 16 * c + (le >> 4)) * LDP + h * 128 + (le & 15) * 8 + P_ZA;
#pragma unroll
      for (int ps = 0; ps < 4; ++ps) zr[ps] = *(const u32x4*)(pz + (size_t)ps * 4 * LDP); }
    float lq0, lq1, lq2, lq3;
    { const float* lamq = ARGP(6) + l * 256; lq0 = lamq[le]; lq1 = lamq[64 + le]; lq2 = lamq[128 + le]; lq3 = lamq[192 + le]; }
    f32x4 g0, g1;
    { const float* nap = ARGP(7) + l * 512 + h * 128 + (le & 15) * 8; g0 = *(const f32x4*)nap; g1 = *(const f32x4*)(nap + 4); }
    lsum = half_swap_add(lsum);
    if (e_hi == 0) wsf[32 + e_r32] = rcp(lsum);
    asm volatile("s_waitcnt lgkmcnt(0)" ::: "memory");
    LAS float* XW = (LAS float*)(F.lds) + (c * 4 + wq) * 2048;
    LAS float* XR = (LAS float*)(F.lds) + ((1 - c) * 4 + wq) * 2048;
    LAS float* ST = (LAS float*)(F.lds + 65536) + (c * 4 + wq) * 2048;
#define EPI_SEND(OB) do { _Pragma("unroll") for (int rr = 0; rr < 8; ++rr) { const float rlr = wsf[32 + crow((OB) + rr, e_hi)]; \
        _Pragma("unroll") for (int d0 = 0; d0 < 4; ++d0) XW[(d0 * 8 + rr) * 64 + le] = o[d0][(OB) + rr] * rlr; } } while (0)
    if (c == 0) EPI_SEND(8); else EPI_SEND(0);
#undef EPI_SEND
    AT_WAIT_BAR(0);
    const float lam = expf(wave_sum(lq0 * lq1, le)) - expf(wave_sum(lq2 * lq3, le)) + lam_init;
    const float kown = c == 0 ? 1.f : -lam, kpar = c == 0 ? -lam : 1.f;
#define EPI_FIN(RB) do { _Pragma("unroll") for (int rr = 0; rr < 8; ++rr) { float ss = 0.f; const float rlr = wsf[32 + crow((RB) + rr, e_hi)] * kown; \
        _Pragma("unroll") for (int d0 = 0; d0 < 4; ++d0) { const float v = o[d0][(RB) + rr] * rlr + kpar * XR[(d0 * 8 + rr) * 64 + le]; o[d0][(RB) + rr] = v; ss += v * v; } \
        ss += bperm(ss, le ^ 1); ss += bperm(ss, le ^ 2); ss += bperm(ss, le ^ 4); ss += bperm(ss, le ^ 8); ss += bperm(ss, le ^ 16); \
        const float rs = rsqrtf(ss * (1.f / 128.f) + EPS) * (1.f - lam_init); \
        _Pragma("unroll") for (int d0 = 0; d0 < 4; ++d0) ST[crow(rr, e_hi) * 128 + d0 * 32 + e_r32] = o[d0][(RB) + rr] * rs; } } while (0)
    if (c == 0) EPI_FIN(0); else EPI_FIN(8);
#undef EPI_FIN
    asm volatile("s_waitcnt lgkmcnt(0)" ::: "memory");
    { const int ch = le & 15;
      bf16_t* pr0 = PROJ + (rowbase + q0 + wq * 32 + 16 * c + (le >> 4)) * LDP + h * 128 + ch * 8;
#pragma unroll
      for (int ps = 0; ps < 4; ++ps) {
          const int row = ps * 4 + (le >> 4);
          const f32x4 v0 = *(LAS const f32x4*)(ST + row * 128 + ch * 8), v1 = *(LAS const f32x4*)(ST + row * 128 + ch * 8 + 4);
          bf16_t* pr = pr0 + (size_t)ps * 4 * LDP;
          const u32x4 z = zr[ps];
          u32x4 w;
          w.x = cvtpk(v0[0] * g0[0] * silu(bflo(z.x)), v0[1] * g0[1] * silu(bfhi(z.x)));
          w.y = cvtpk(v0[2] * g0[2] * silu(bflo(z.y)), v0[3] * g0[3] * silu(bfhi(z.y)));
          w.z = cvtpk(v1[0] * g1[0] * silu(bflo(z.z)), v1[1] * g1[1] * silu(bfhi(z.z)));
          w.w = cvtpk(v1[2] * g1[2] * silu(bflo(z.w)), v1[3] * g1[3] * silu(bfhi(z.w)));

#ifdef HO_AMG
          st16_wt(F.ws, (size_t)((unsigned char*)(pr + P_YA) - F.ws), w);
#else
          *(u32x4*)(pr + P_YA) = w;
#endif

      } }
    AT_WAIT_BAR(0);
#else
    int le = lane; asm volatile("" : "+v"(le));
    const int e_r32 = le & 31, e_hi = le >> 5;
#ifdef AT_ZPRE
    u32x4 zr[8];
    if (c == 0) {
        const bf16_t* pz = PROJ + (rowbase + q0 + wq * 32 + (le >> 4)) * LDP + h * 128 + (le & 15) * 8 + P_ZA;
#pragma unroll
        for (int ps = 0; ps < 8; ++ps) zr[ps] = *(const u32x4*)(pz + (size_t)ps * 4 * LDP);
    }
#ifdef AT_LAM_LATE
    float lq0, lq1, lq2, lq3;
    { const float* lamq = ARGP(6) + l * 256; lq0 = lamq[le]; lq1 = lamq[64 + le]; lq2 = lamq[128 + le]; lq3 = lamq[192 + le]; }
#endif
    f32x4 g0p = {0.f, 0.f, 0.f, 0.f}, g1p = g0p;
    if (c == 0) { const float* nap = ARGP(7) + l * 512 + h * 128 + (le & 15) * 8; g0p = *(const f32x4*)nap; g1p = *(const f32x4*)(nap + 4); }
#endif
    lsum = half_swap_add(lsum);
    if (e_hi == 0) wsf[32 + e_r32] = rcp(lsum);
    asm volatile("s_waitcnt lgkmcnt(0)" ::: "memory");
    LAS float* X = (LAS float*)(F.lds) + wq * 4096;
    if (c == 1) {
#pragma unroll
        for (int r = 0; r < 16; ++r) { const float rlr = wsf[32 + crow(r, e_hi)];
#pragma unroll
            for (int d0 = 0; d0 < 4; ++d0) X[(d0 * 16 + r) * 64 + le] = o[d0][r] * rlr; }
    }
    AT_WAIT_BAR(0);
    if (c == 0) {
#ifdef AT_LAM_LATE
        const float lam = expf(wave_sum(lq0 * lq1, le)) - expf(wave_sum(lq2 * lq3, le)) + lam_init;
#endif
        LAS float* ST = (LAS float*)(F.lds + 65536) + wq * 4096;
#pragma unroll
        for (int r = 0; r < 16; ++r) { float ss = 0.f; const float rlr = wsf[32 + crow(r, e_hi)];
#pragma unroll
            for (int d0 = 0; d0 < 4; ++d0) { const float v = o[d0][r] * rlr - lam * X[(d0 * 16 + r) * 64 + le]; o[d0][r] = v; ss += v * v; }
            ss += bperm(ss, le ^ 1); ss += bperm(ss, le ^ 2); ss += bperm(ss, le ^ 4); ss += bperm(ss, le ^ 8); ss += bperm(ss, le ^ 16);
            const float rs = rsqrtf(ss * (1.f / 128.f) + EPS) * (1.f - lam_init);
#pragma unroll
            for (int d0 = 0; d0 < 4; ++d0) ST[crow(r, e_hi) * 128 + d0 * 32 + e_r32] = o[d0][r] * rs; }
        asm volatile("s_waitcnt lgkmcnt(0)" ::: "memory");
        const int ch = le & 15;
        const float* na = ARGP(7) + l * 512 + h * 128 + ch * 8;
#ifdef AT_ZPRE
        const f32x4 g0 = g0p, g1 = g1p; (void)na;
#else
        const f32x4 g0 = *(const f32x4*)na, g1 = *(const f32x4*)(na + 4);
#endif
        bf16_t* pr0 = PROJ + (rowbase + q0 + wq * 32 + (le >> 4)) * LDP + h * 128 + ch * 8;
#ifdef AT_ZPRE
#pragma unroll
#else
#pragma unroll 2
#endif
        for (int ps = 0; ps < 8; ++ps) {
            const int row = ps * 4 + (le >> 4);
            const f32x4 v0 = *(LAS const f32x4*)(ST + row * 128 + ch * 8), v1 = *(LAS const f32x4*)(ST + row * 128 + ch * 8 + 4);
            bf16_t* pr = pr0 + (size_t)ps * 4 * LDP;
#ifdef AT_ZPRE
            const u32x4 z = zr[ps];
#else
            const u32x4 z = *(const u32x4*)(pr + P_ZA);
#endif
            u32x4 w;
            w.x = cvtpk(v0[0] * g0[0] * silu(bflo(z.x)), v0[1] * g0[1] * silu(bfhi(z.x)));
            w.y = cvtpk(v0[2] * g0[2] * silu(bflo(z.y)), v0[3] * g0[3] * silu(bfhi(z.y)));
            w.z = cvtpk(v1[0] * g1[0] * silu(bflo(z.z)), v1[1] * g1[1] * silu(bfhi(z.z)));
            w.w = cvtpk(v1[2] * g1[2] * silu(bflo(z.w)), v1[3] * g1[3] * silu(bfhi(z.w)));

#ifdef HO_AMG
          st16_wt(F.ws, (size_t)((unsigned char*)(pr + P_YA) - F.ws), w);
#else
          *(u32x4*)(pr + P_YA) = w;
#endif

        }
    }
    AT_WAIT_BAR(0);
#endif
#undef AT_DMA
}

__device__ __forceinline__ void attn_prefetch(Frame& F, int b, int h, int qb) {
    int lane_ = F.lane; asm volatile("" : "+v"(lane_));
    const int lane = lane_, wid = F.wave;
    const bf16_t* PROJ = (const bf16_t*)(F.ws + WS_PROJ);
    const int NT = 2 * (qb + 1);
    const unsigned lds0 = (unsigned)(uintptr_t)F.lds;
    const int kr0 = 8 * wid + (lane >> 4), kr1 = kr0 + 4;
    const unsigned kof0 = (unsigned)(kr0 * LDP + P_KA + h * 128 + ((lane & 15) ^ (kr0 & 15)) * 8) * 2u;
    const unsigned kof1 = (unsigned)(kr1 * LDP + P_KA + h * 128 + ((lane & 15) ^ (kr1 & 15)) * 8) * 2u;
    const unsigned vof0 = (unsigned)(((lane >> 2) + 16 * (wid & 3)) * LDP + P_VA + h * 128 + (lane & 3) * 8 + (wid >> 2) * 32) * 2u;
    const bf16_t* KVb = PROJ + (size_t)b * SEQ * LDP;
#define AT_DMA_P(t, slot) do { const bf16_t* tb_ = KVb + (size_t)(t) * 64 * LDP; const unsigned sb_ = lds0 + (unsigned)(slot) * AT_SLOT; \
        glds16s(tb_, kof0, (unsigned)__builtin_amdgcn_readfirstlane(sb_ + wid * 2048)); \
        glds16s(tb_, kof1, (unsigned)__builtin_amdgcn_readfirstlane(sb_ + wid * 2048 + 1024)); \
        glds16s(tb_, vof0, (unsigned)__builtin_amdgcn_readfirstlane(sb_ + AT_VOFF + wid * 1024)); \
        glds16s(tb_, vof0 + 128u, (unsigned)__builtin_amdgcn_readfirstlane(sb_ + AT_VOFF + (wid + 8) * 1024)); } while (0)
    AT_DMA_P(NT - 1, 0); AT_DMA_P(NT - 2, 1); if (NT > 2) AT_DMA_P(NT - 3, 2);
#undef AT_DMA_P
}

#ifdef HO_M123
#define WT_ST32(p, x) __hip_atomic_store((unsigned*)(p), (unsigned)(x), __ATOMIC_RELAXED, __HIP_MEMORY_SCOPE_AGENT)
#define WT_STF(p, x)  __hip_atomic_store((unsigned*)(p), __float_as_uint(x), __ATOMIC_RELAXED, __HIP_MEMORY_SCOPE_AGENT)
constexpr int CW_F1 = 3072, CW_F2 = 3584;
__device__ __forceinline__ void ho_publish(Frame& F, int word) {
    asm volatile("s_waitcnt vmcnt(0)" ::: "memory"); __syncthreads();
    if (is_t0(F.wave)) __hip_atomic_store((unsigned*)(F.ws + WS_CTL) + word, 1u, __ATOMIC_RELAXED, __HIP_MEMORY_SCOPE_AGENT);
}
template <int N, bool ACQ = true> __device__ __forceinline__ void ho_wait(Frame& F, int word0) {
    if (F.wave == 0) { const int ln = lane_now(); unsigned* pf = (unsigned*)(F.ws + WS_CTL) + word0; unsigned sp_ = 0;
        for (;;) { bool ok = true;
#pragma unroll
            for (int k = 0; k < (N + 63) / 64; ++k) { const int i = ln + 64 * k; if (i < N) ok = ok && (xb_ld(pf + i) != 0u); }
            if (__all(ok)) break; __builtin_amdgcn_s_sleep(1); if (++sp_ > XB_SPIN_CAP) break; }
        if (ACQ && ln == 0) { __builtin_amdgcn_fence(__ATOMIC_ACQUIRE, "agent"); asm volatile("s_waitcnt vmcnt(0)" ::: "memory"); } }
    __syncthreads();
}
constexpr int CW_AM = 7552;
struct AllAM { unsigned char* ws; int word0; static constexpr bool ON = true;
    __device__ __forceinline__ void operator()(int wid) const { if (wid == 0) { const int ln = lane_now(); unsigned* pf = (unsigned*)(ws + WS_CTL) + word0; unsigned sp_ = 0;
        for (;;) { bool ok = true;
#pragma unroll
            for (int k = 0; k < 4; ++k) ok = ok && (xb_ld(pf + ln + 64 * k) != 0u);
            if (__all(ok)) break; __builtin_amdgcn_s_sleep(1); if (++sp_ > XB_SPIN_CAP) break; }
        asm volatile("s_waitcnt vmcnt(0)" ::: "memory"); } } };
#ifdef HO_G1
constexpr int CW_G1 = 256;
__device__ __forceinline__ void ho_wait_m1(Frame& F, int l) {
    if (F.wave == 0) { const int ln = lane_now();
        const int bh = F.vcu >> 4, j = F.vcu & 15, bb = bh >> 2, h = bh & 3;
        const int pm = bb * 16 + j, pnK = 10 + (h >> 1), pnV = 12 + (h >> 1);
        const int sel = ln >> 1, which = ln & 1;
        const bool need = ln < 6 && !(sel == 2 && j == 0);
        const int pmt = sel == 2 ? pm - 1 : pm, pnt = sel == 1 ? pnV : pnK;
        const int wgid = (pmt >> 2) * (WGM * (NLA / BM)) + pnt * WGM + (pmt & 3), q_ = (M / BM) * (NLA / BM) / NXCD, L = (wgid % q_) * NXCD + wgid / q_;
        const int prod = L < 4 * 256 ? (L & 255) : 2 * (L - 4 * 256) + which;
#ifdef HO_G1EARLY
        unsigned* pf = (unsigned*)(F.ws + WS_CTL) + (L < 4 * 256 ? (l == 0 ? 768 : 1664) : CW_G1 + 256 * l) + (need ? prod : 0); unsigned sp_ = 0;
#else
        unsigned* pf = (unsigned*)(F.ws + WS_CTL) + CW_G1 + 256 * l + (need ? prod : 0); unsigned sp_ = 0;
#endif
        for (;;) { const bool ok = !need || xb_ld(pf) != 0u; if (__all(ok)) break; __builtin_amdgcn_s_sleep(1); if (++sp_ > XB_SPIN_CAP) break; }
#ifndef HO_NOACQ
        if (ln == 0) { __builtin_amdgcn_fence(__ATOMIC_ACQUIRE, "agent"); asm volatile("s_waitcnt vmcnt(0)" ::: "memory"); }
#endif
        }
    __syncthreads();
}
#endif
#else
#define WT_ST32(p, x) (*(unsigned*)(p) = (unsigned)(x))
#define WT_STF(p, x)  (*(float*)(p) = (x))
#endif
#define LDS_BAR() asm volatile("s_waitcnt lgkmcnt(0)\n\ts_barrier" ::: "memory")
#define LDS_BAR_() asm volatile("s_waitcnt lgkmcnt(0)\n\ts_barrier" ::: "memory")
__device__ __forceinline__ float logsig(float x) { return fminf(x, 0.f) - __builtin_amdgcn_logf(1.f + ex2(-fabsf(x) * LOG2E)) * 0.6931471805599453f; }
__device__ __forceinline__ float fexp(float x) { return ex2(x * LOG2E); }
template <int CTRL, int ROWMASK> __device__ __forceinline__ float dpp_f(float ident, float v) {
    return __uint_as_float((unsigned)__builtin_amdgcn_update_dpp((int)__float_as_uint(ident), (int)__float_as_uint(v), CTRL, ROWMASK, 0xF, false)); }
__device__ __forceinline__ float wave_prefix_sum(float v, int) {
    v += dpp_f<0x111, 0xF>(0.f, v); v += dpp_f<0x112, 0xF>(0.f, v); v += dpp_f<0x114, 0xF>(0.f, v); v += dpp_f<0x118, 0xF>(0.f, v);
    v += dpp_f<0x142, 0xA>(0.f, v); v += dpp_f<0x143, 0xC>(0.f, v);
    return v;
}
__device__ __forceinline__ float wave_prefix_max(float v, int) {
    const float NI = -INFINITY;
    v = fmaxf(v, dpp_f<0x111, 0xF>(NI, v)); v = fmaxf(v, dpp_f<0x112, 0xF>(NI, v)); v = fmaxf(v, dpp_f<0x114, 0xF>(NI, v)); v = fmaxf(v, dpp_f<0x118, 0xF>(NI, v));
    v = fmaxf(v, dpp_f<0x142, 0xA>(NI, v)); v = fmaxf(v, dpp_f<0x143, 0xC>(NI, v));
    return v;
}
__device__ __forceinline__ float wave_max(float v, int lane) { return __uint_as_float((unsigned)__builtin_amdgcn_readlane((int)__float_as_uint(wave_prefix_max(v, lane)), 63)); }
__device__ __forceinline__ void conv8(const bf16_t* PROJ, long row0, bool first, int pcol, const float* cw, int cp, int rg, float (&y)[8][2]) {
    float x[11][2];
#pragma unroll
    for (int i = 0; i < 11; ++i) { const int rr = 8 * rg + i - 3;
        unsigned w = 0u; if (!(first && rr < 0)) w = *(const unsigned*)(PROJ + (row0 + rr) * LDP + pcol + 2 * cp);
        x[i][0] = bflo(w); x[i][1] = bfhi(w); }
    float wt[4][2];
#pragma unroll
    for (int k = 0; k < 4; ++k) { const f32x2 t = *(const f32x2*)(cw + k * 1024 + 2 * cp); wt[k][0] = t[0]; wt[k][1] = t[1]; }
#pragma unroll
    for (int r = 0; r < 8; ++r)
#pragma unroll
        for (int e = 0; e < 2; ++e) { float a = wt[0][e] * x[r][e]; a += wt[1][e] * x[r + 1][e]; a += wt[2][e] * x[r + 2][e]; a += wt[3][e] * x[r + 3][e]; y[r][e] = silu(a); }
}

struct M1Pre { u32x4 v[2]; unsigned k[11]; float ig, fg; };
__device__ __forceinline__ void conv_load(const bf16_t* PROJ, long row0, bool first, int pcol, int cp, int rg, unsigned (&x)[11]);
__device__ __forceinline__ void conv_calc(const unsigned (&x)[11], const float (&wt)[4][2], float (&y)[8][2]);
__device__ __forceinline__ void m1_load(Frame& F, int item, int tid, M1Pre& P) {
    const int lane = tid & 63;
    const int bh = item >> 6, ch = item & 63, b = bh >> 2, h = bh & 3; const long row0 = (long)b * SEQ + ch * 64;
    const bf16_t* PROJ = (const bf16_t*)(F.ws + WS_PROJ);
#pragma unroll
    for (int ps = 0; ps < 2; ++ps) { const int row = (tid >> 4) + 32 * ps, chk = tid & 15; P.v[ps] = *(const u32x4*)(PROJ + (row0 + row) * LDP + P_VB + h * 128 + chk * 8); }
    conv_load(PROJ, row0, ch == 0, P_KB + h * 128, tid & 63, tid >> 6, P.k);
    P.ig = 0.f; P.fg = 0.f;
#ifdef M1_NOBAR1
    { const float* GATES = (const float*)(F.ws + WS_GATES); P.ig = GATES[(row0 + lane) * 8 + h]; P.fg = GATES[(row0 + lane) * 8 + 4 + h]; }
#else
    if (F.wave == 0) { const float* GATES = (const float*)(F.ws + WS_GATES); P.ig = GATES[(row0 + lane) * 8 + h]; P.fg = GATES[(row0 + lane) * 8 + 4 + h]; }
#endif
}
__device__ __forceinline__ void mlstm1_run(Frame& F, int l, int item0) {
    int tid0 = F.tid; asm volatile("" : "+v"(tid0));
    const int wave = F.wave, h = (item0 >> 6) & 3;
    LAS unsigned char* KW = F.lds; LAS unsigned char* VT = F.lds + 16384; LAS unsigned char* STG = F.lds + 32768; LAS float* wk = (LAS float*)(F.lds + 69632);
    float* MSC = (float*)(F.ws + WS_MSC);
    float wt[4][2];
    { const float* cw = ARGP(5) + (size_t)l * 4096 + 512 + h * 128 + 2 * (tid0 & 63);
#pragma unroll
      for (int k = 0; k < 4; ++k) { const f32x2 t = *(const f32x2*)(cw + k * 1024); wt[k][0] = t[0]; wt[k][1] = t[1]; } }
    const float bi = ARGP(4)[l * 8 + h], bf_ = ARGP(4)[l * 8 + 4 + h];
    M1Pre P;
    m1_load(F, item0, tid0, P);
#pragma unroll 1
    for (int it = 0; it < 4; ++it) {
        const int item = item0 + it;
        int tid = tid0; asm volatile("" : "+v"(tid));
        int lane = tid & 63; const int cp = tid & 63, rg = tid >> 6;
#ifdef M1_NOBAR1
        float wkv;
        { const float bs = wave_prefix_sum(logsig(P.fg + bf_), lane), bL = __uint_as_float((unsigned)__builtin_amdgcn_readlane((int)__float_as_uint(bs), 63));
          const float a = bL - bs + P.ig + bi, ml = wave_max(a, lane);
          wkv = fexp(a - ml) * KSCALE;
          if (wave == 0 && lane == 0) { WT_STF(MSC + item, bL); WT_STF(MSC + 1024 + item, ml); } }
        float y[8][2];
        conv_calc(P.k, wt, y);
#pragma unroll
        for (int r = 0; r < 8; ++r) { const int s = 8 * rg + r, d = 2 * cp; const float w = __uint_as_float((unsigned)__builtin_amdgcn_readlane((int)__float_as_uint(wkv), 8 * wave + r));
#else
        if (wave == 0) {
            const float bs = wave_prefix_sum(logsig(P.fg + bf_), lane), bL = __uint_as_float((unsigned)__builtin_amdgcn_readlane((int)__float_as_uint(bs), 63));
            const float a = bL - bs + P.ig + bi, ml = wave_max(a, lane);
            wk[lane] = fexp(a - ml) * KSCALE;
            if (lane == 0) { MSC[item] = bL; MSC[1024 + item] = ml; }
        }
        float y[8][2];
        conv_calc(P.k, wt, y);
        LDS_BAR();
#pragma unroll
        for (int r = 0; r < 8; ++r) { const int s = 8 * rg + r, d = 2 * cp; const float w = wk[s];
#endif
            *(LAS unsigned*)(KW + (d >> 5) * 4096 + (s >> 4) * 1024 + (s & 15) * 64 + (d & 31) * 2) = cvtpk(y[r][0] * w, y[r][1] * w); }
#pragma unroll
        for (int ps = 0; ps < 2; ++ps) { const int row = (tid >> 4) + 32 * ps, chk = tid & 15;
            *(LAS u32x4*)(VT + (chk >> 2) * 4096 + (row >> 4) * 1024 + (row & 15) * 64 + (chk & 3) * 16) = P.v[ps]; }
        LDS_BAR();
        asm volatile("" : "+v"(tid)); lane = tid & 63;
        const int hi = lane >> 5, r32 = lane & 31;
        if (it + 1 < 4) m1_load(F, item + 1, tid, P);
#ifdef M1_DN4
        { const int d = tid >> 2, part = tid & 3; float a = 0.f;
#pragma unroll
            for (int s = 0; s < 16; ++s) a += bf1(*(LAS const bf16_t*)(KW + (d >> 5) * 4096 + part * 1024 + s * 64 + (d & 31) * 2));
            a += dpp_f<0xB1, 0xF>(0.f, a); a += dpp_f<0x4E, 0xF>(0.f, a);
            if (part == 0) WT_STF((float*)(F.ws + WS_DN) + (size_t)item * 128 + d, a); }
#else
        if (tid < 128) { const int d = tid; float a = 0.f;
#pragma unroll 8
            for (int s = 0; s < 64; ++s) a += bf1(*(LAS const bf16_t*)(KW + (d >> 5) * 4096 + (s >> 4) * 1024 + (s & 15) * 64 + (d & 31) * 2));
            ((float*)(F.ws + WS_DN))[(size_t)item * 128 + d] = a; }
#endif
        const int db = wave >> 1, eb0 = 2 * (wave & 1);
        const int trb = ((lane >> 4) & 1) * 32 + (lane & 3) * 8 + (4 * hi + ((lane & 15) >> 2)) * 64;
        f32x16 acc[2];
#pragma unroll
        for (int r = 0; r < 16; ++r) { acc[0][r] = 0.f; acc[1][r] = 0.f; }
#pragma unroll
        for (int ks = 0; ks < 4; ++ks) {
            const bf16x8 a = tr2(KW + db * 4096 + ks * 1024 + trb);
            const bf16x8 b0 = tr2(VT + eb0 * 4096 + ks * 1024 + trb), b1 = tr2(VT + (eb0 + 1) * 4096 + ks * 1024 + trb);
#ifdef M1_SWAP
            acc[0] = __builtin_amdgcn_mfma_f32_32x32x16_bf16(b0, a, acc[0], 0, 0, 0);
            acc[1] = __builtin_amdgcn_mfma_f32_32x32x16_bf16(b1, a, acc[1], 0, 0, 0);
#else
            acc[0] = __builtin_amdgcn_mfma_f32_32x32x16_bf16(a, b0, acc[0], 0, 0, 0);
            acc[1] = __builtin_amdgcn_mfma_f32_32x32x16_bf16(a, b1, acc[1], 0, 0, 0);
#endif
        }
#ifdef M1_SWAP
        constexpr int SPITCH = 272;
#pragma unroll
        for (int i = 0; i < 2; ++i)
#pragma unroll
            for (int g = 0; g < 4; ++g) { const int d = 32 * db + r32, e = 32 * (eb0 + i) + 8 * g + 4 * hi;
                *(LAS u32x2*)(STG + d * SPITCH + e * 2) = (u32x2){cvtpk(acc[i][4 * g], acc[i][4 * g + 1]), cvtpk(acc[i][4 * g + 2], acc[i][4 * g + 3])}; }
        LDS_BAR();
        bf16_t* CST = (bf16_t*)(F.ws + WS_CST) + (size_t)item * 16384;
#pragma unroll
#ifdef HO_M123
        for (int j = 0; j < 4; ++j) { const int idx = tid + 512 * j;
            __builtin_amdgcn_raw_buffer_store_b128(*(LAS const u32x4*)(STG + (idx >> 4) * SPITCH + (idx & 15) * 16), __builtin_amdgcn_make_buffer_rsrc((void*)(F.ws + WS_CST), 0, 33554432, 0x00020000),
                                                   (unsigned)(item * 32768 + idx * 16), 0, 16); (void)CST; }
#else
        for (int j = 0; j < 4; ++j) { const int idx = tid + 512 * j; *(u32x4*)(CST + idx * 8) = *(LAS const u32x4*)(STG + (idx >> 4) * SPITCH + (idx & 15) * 16); }
#endif
#else
#pragma unroll
        for (int i = 0; i < 2; ++i)
#pragma unroll
            for (int r = 0; r < 16; ++r) { const int d = 32 * db + crow(r, hi), e = 32 * (eb0 + i) + r32;
                *(LAS bf16_t*)(STG + d * 256 + e * 2) = (bf16_t)(cvtpk(acc[i][r], 0.f) & 0xffffu); }
        LDS_BAR();
        bf16_t* CST = (bf16_t*)(F.ws + WS_CST) + (size_t)item * 16384;
#pragma unroll
        for (int j = 0; j < 4; ++j) { const int idx = tid + 512 * j; *(u32x4*)(CST + idx * 8) = *(LAS const u32x4*)(STG + idx * 16); }
#endif
    }
#ifdef HO_M123
    ho_publish(F, CW_F1 + 256 * l + F.vcu);
#else
    LDS_BAR();
#endif
}

#ifndef SC_B
#define SC_B 21
#endif
__device__ __forceinline__ void mlstm_scan(Frame& F, int l = 0) {
    int tid_ = F.tid; asm volatile("" : "+v"(tid_));
    const int bh = F.vcu >> 4, part = F.vcu & 15, tid = tid_;
    if (bh >= 16) return;
#ifdef HO_M123
#ifdef HO_G1
    if (F.wave == 0) { const int ln = lane_now(); unsigned* pg = (unsigned*)(F.ws + WS_CTL) + CW_G1 + 256 * l; bool okg = true;
#pragma unroll
        for (int k = 0; k < 4; ++k) okg = okg && (xb_ld(pg + ln + 64 * k) != 0u);
        const bool allg = __all(okg); if (ln == 0) ((volatile LAS unsigned*)(F.lds + MISC_OFF))[26] = allg ? 1u : 0u; }
#endif
#ifdef HO_NOACQ
    ho_wait<16, false>(F, CW_F1 + 256 * l + 16 * bh);
#else
    ho_wait<16>(F, CW_F1 + 256 * l + 16 * bh);
#endif
#endif
    const float* MSC = (const float*)(F.ws + WS_MSC); float* MST = (float*)(F.ws + WS_MSC) + 2048;
#ifdef AT_PREFETCH
    LAS float* sbl = (LAS float*)(F.lds + WSF_OFF);
#else
    LAS float* sbl = (LAS float*)F.lds;
#endif
    LAS float* sml = sbl + 64; LAS float* sm = sbl + 128; LAS float* sf = sbl + 256; LAS float* sg = sbl + 320;
    if (tid < 64) {
        const float bl = MSC[bh * 64 + tid], ml = MSC[1024 + bh * 64 + tid];
        float A = bl, B = ml;
#define MP_STEP(CTRL, RM) do { const float Ap = dpp_f<CTRL, RM>(0.f, A), Bp = dpp_f<CTRL, RM>(-INFINITY, B); B = fmaxf(Bp + A, B); A = Ap + A; } while (0)
        MP_STEP(0x111, 0xF); MP_STEP(0x112, 0xF); MP_STEP(0x114, 0xF); MP_STEP(0x118, 0xF); MP_STEP(0x142, 0xA); MP_STEP(0x143, 0xC);
#undef MP_STEP
        const float mn = fmaxf(A, B);
        sm[tid + 1] = mn; if (tid == 0) sm[0] = 0.f;
        asm volatile("s_waitcnt lgkmcnt(0)" ::: "memory");
        const float mj = sm[tid];
        if (tid < 63) { sf[tid] = fexp(bl + mj - mn); sg[tid] = fexp(ml - mn); if (part == 0) WT_STF(MST + bh * 64 + tid + 1, mn); }
    }
    if (part == 0 && tid == 0) WT_STF(MST + bh * 64, 0.f);
    LDS_BAR_();
    unsigned* base = (unsigned*)(F.ws + WS_CST) + (size_t)bh * 64 * 8192 + part * 512 + tid;
    float* DN = (float*)(F.ws + WS_DN) + (size_t)bh * 64 * 128;
    float c0 = 0.f, c1 = 0.f, nn = 0.f;
    const bool nown = (part == 0 && tid < 128);
#ifdef SCAN_PIPE
#define SC_LOAD(d, dn, j0) do { _Pragma("unroll") for (int k = 0; k < 21; ++k) { d[k] = base[(size_t)((j0) + k) * 8192]; dn[k] = nown ? DN[((j0) + k) * 128 + tid] : 0.f; } } while (0)
#define SC_FOLD(d, dn, j0) do { _Pragma("unroll") for (int k = 0; k < 21; ++k) { const int j = (j0) + k; const float f = sf[j], g = sg[j]; \
            c0 = f * c0 + g * bflo(d[k]); c1 = f * c1 + g * bfhi(d[k]); base[(size_t)j * 8192] = cvtpk(c0, c1); \
            if (nown) { nn = f * nn + g * dn[k]; DN[j * 128 + tid] = nn; } } } while (0)
    { unsigned dA[21], dB[21]; float nA[21], nB[21];
#if SCAN_PIPE == 2
      unsigned dC[21]; float nC[21];
      SC_LOAD(dA, nA, 0); SC_LOAD(dB, nB, 21); SC_LOAD(dC, nC, 42);
      SC_FOLD(dA, nA, 0); SC_FOLD(dB, nB, 21); SC_FOLD(dC, nC, 42); }
#else
      SC_LOAD(dA, nA, 0); SC_LOAD(dB, nB, 21);
      SC_FOLD(dA, nA, 0);
      SC_LOAD(dA, nA, 42);
      SC_FOLD(dB, nB, 21);
      SC_FOLD(dA, nA, 42); }
#endif
#undef SC_LOAD
#undef SC_FOLD
#else
    for (int j0 = 0; j0 < 63; j0 += SC_B) {
        unsigned d[SC_B]; float dn[SC_B];
#pragma unroll
        for (int k = 0; k < SC_B; ++k) { d[k] = base[(size_t)(j0 + k) * 8192]; dn[k] = nown ? DN[(j0 + k) * 128 + tid] : 0.f; }
#pragma unroll
        for (int k = 0; k < SC_B; ++k) { const int j = j0 + k; const float f = sf[j], g = sg[j];
            c0 = f * c0 + g * bflo(d[k]); c1 = f * c1 + g * bfhi(d[k]);
            WT_ST32(base + (size_t)j * 8192, cvtpk(c0, c1));
            if (nown) { nn = f * nn + g * dn[k]; WT_STF(DN + j * 128 + tid, nn); }
        }
    }
#endif
#ifdef HO_M123
    ho_publish(F, CW_F2 + 256 * l + F.vcu);
#endif
}

__device__ __forceinline__ void conv_load(const bf16_t* PROJ, long row0, bool first, int pcol, int cp, int rg, unsigned (&x)[11]) {
    const char* base = (const char*)(PROJ + (row0 - 3) * LDP + pcol);
    const unsigned off = (unsigned)((8 * rg) * LDP + 2 * cp) * 2u;
#pragma unroll
    for (int i = 0; i < 11; ++i) { x[i] = 0u; if (!(first && 8 * rg + i < 3)) x[i] = *(const unsigned*)(base + (size_t)(off + (unsigned)(i * LDP * 2))); }
}
__device__ __forceinline__ void conv_calc(const unsigned (&x)[11], const float (&wt)[4][2], float (&y)[8][2]) {
#pragma unroll
    for (int r = 0; r < 8; ++r) {
        float a0 = wt[0][0] * bflo(x[r]), a1 = wt[0][1] * bfhi(x[r]);
#pragma unroll
        for (int k = 1; k < 4; ++k) { a0 += wt[k][0] * bflo(x[r + k]); a1 += wt[k][1] * bfhi(x[r + k]); }
        y[r][0] = silu(a0); y[r][1] = silu(a1); }
}
struct M3Pre { u32x4 v[2]; float ig, fg, mj, nst; };
__device__ __forceinline__ void m3_load(Frame& F, int item, int tid, M3Pre& P, unsigned raw_lds) {
    const int lane = tid & 63, wave = F.wave;
    const int bh = item >> 6, ch = item & 63, b = bh >> 2, h = bh & 3; const long row0 = (long)b * SEQ + ch * 64;
    const bf16_t* PROJ = (const bf16_t*)(F.ws + WS_PROJ);
    { const bf16_t* rb = PROJ + (row0 - 3) * LDP + h * 128;
      const unsigned lo = (unsigned)((lane >> 4) * LDP + (lane & 15) * 8) * 2u;
      for (int pc = wave; pc < 34; pc += NWAVES) { const int tsr = pc >= 17 ? 1 : 0, pp = pc - 17 * tsr;
          glds16s(rb, lo + (unsigned)((4 * pp) * LDP + (tsr ? P_KB : P_QB)) * 2u, (unsigned)__builtin_amdgcn_readfirstlane(raw_lds + tsr * 17408 + pp * 1024)); } }
#pragma unroll
    for (int ps = 0; ps < 2; ++ps) { const int row = (tid >> 4) + 32 * ps, chk = tid & 15; P.v[ps] = *(const u32x4*)(PROJ + (row0 + row) * LDP + P_VB + h * 128 + chk * 8); }
    P.ig = 0.f; P.fg = 0.f; P.mj = 0.f; P.nst = 0.f;
    if (wave == 0) { const float* GATES = (const float*)(F.ws + WS_GATES); P.ig = GATES[(row0 + lane) * 8 + h]; P.fg = GATES[(row0 + lane) * 8 + 4 + h]; P.mj = ((const float*)(F.ws + WS_MSC) + 2048)[item]; }
    else if (wave <= 2) { if (ch > 0) P.nst = ((const float*)(F.ws + WS_DN))[(size_t)(item - 1) * 128 + (tid - 64)]; }
}
__device__ __forceinline__ void m3_load_c(Frame& F, int item, int lane, unsigned ct_lds) {
    if ((item & 63) == 0) return;
    const bf16_t* CS = (const bf16_t*)(F.ws + WS_CST) + (size_t)(item - 1) * 16384;
#pragma unroll
    for (int j = 0; j < 4; ++j) { const int pc = F.wave * 4 + j, eb = pc >> 3, rgp = pc & 7;
        glds16s(CS, (unsigned)((16 * rgp + (lane >> 2)) * 128 + 32 * eb + (lane & 3) * 8) * 2u, (unsigned)__builtin_amdgcn_readfirstlane(ct_lds + eb * 8192 + rgp * 1024)); }
}
__device__ __forceinline__ void conv_lds(LAS const unsigned char* raw, bool first, int cp, int rg, LAS const float* cw, float (&y)[8][2]) {
    float wt[4][2];
#pragma unroll
    for (int k = 0; k < 4; ++k) { const f32x2 t = *(LAS const f32x2*)(cw + k * 128 + 2 * cp); wt[k][0] = t[0]; wt[k][1] = t[1]; }
    unsigned x[11];
#pragma unroll
    for (int i = 0; i < 11; ++i) { x[i] = *(LAS const unsigned*)(raw + (8 * rg + i) * 256 + cp * 4); if (first && 8 * rg + i < 3) x[i] = 0u; }
    conv_calc(x, wt, y);
}
__device__ __forceinline__ void mlstm3_run(Frame& F, int l, int item0) {
    int tid0 = F.tid; asm volatile("" : "+v"(tid0));
    const int wave = F.wave;
    const int h = (item0 >> 6) & 3;
    bf16_t* PROJ = (bf16_t*)(F.ws + WS_PROJ);
    LAS unsigned char* QT = F.lds; LAS unsigned char* KT = F.lds + 16384; LAS unsigned char* VT = F.lds + 32768; LAS unsigned char* CT = F.lds + 49152;
    LAS float* ST = (LAS float*)(F.lds);
    constexpr int RAW0 = 81920;
    LAS float* SC = (LAS float*)(F.lds + 139264);
    LAS float* gs = SC; LAS float* mx = SC + 64; LAS float* wint = SC + 128; LAS float* dfl = SC + 192; LAS float* qn = SC + 256; LAS float* nst = SC + 320;
    LAS float* nbL = SC + 448; LAS float* cwL = SC + 576;
    LAS float* wsf = (LAS float*)(F.lds + WSF_OFF) + wave * 64;
    const unsigned lds0 = (unsigned)(uintptr_t)F.lds;
    { const int tid = tid0;
    if (tid < 128) nbL[tid] = ARGP(8)[l * 512 + h * 128 + tid];
    { const float* cw = ARGP(5) + (size_t)l * 4096 + h * 128;
      for (int i = tid; i < 1024; i += NTHREADS) { const int qk = i >> 9, k = (i >> 7) & 3, d = i & 127; cwL[i] = cw[k * 1024 + qk * 512 + d]; } } }
    const float bi = ARGP(4)[l * 8 + h], bf_ = ARGP(4)[l * 8 + 4 + h];
    M3Pre P;
    m3_load(F, item0, tid0, P, lds0 + RAW0);
    m3_load_c(F, item0, tid0 & 63, lds0 + 49152);
    WG_BAR();
#pragma unroll 1
    for (int it = 0; it < 4; ++it) {
        const int item = item0 + it, ch = item & 63; const long row0 = (long)(item >> 8) * SEQ + ch * 64;
        int tid = tid0; asm volatile("" : "+v"(tid));
        int lane = tid & 63, cp = tid & 63, rg = tid >> 6;
        TSK(40);
        if (wave == 0) {
            const float bs = wave_prefix_sum(logsig(P.fg + bf_), lane);
            const float g = P.ig + bi - bs, pm = wave_prefix_max(g, lane), mxv = fmaxf(P.mj, pm);
            gs[lane] = g * LOG2E; mx[lane] = mxv * LOG2E; wint[lane] = fexp(P.mj - mxv); dfl[lane] = fexp(-(bs + mxv));
        } else if (wave <= 2) nst[tid - 64] = P.nst;
        { float y[8][2];
          conv_lds(F.lds + RAW0, ch == 0, cp, rg, cwL, y);
#pragma unroll
          for (int r = 0; r < 8; ++r) { const int s = 8 * rg + r, d = 2 * cp; *(LAS unsigned*)(QT + s * 256 + ((((d >> 3) ^ (s & 15))) << 4) + (d & 7) * 2) = cvtpk(y[r][0], y[r][1]); }
          conv_lds(F.lds + RAW0 + 17408, ch == 0, cp, rg, cwL + 512, y);
#pragma unroll
          for (int r = 0; r < 8; ++r) { const int s = 8 * rg + r, d = 2 * cp; *(LAS unsigned*)(KT + s * 256 + ((((d >> 3) ^ (s & 15))) << 4) + (d & 7) * 2) = cvtpk(y[r][0], y[r][1]); } }
#pragma unroll
        for (int ps = 0; ps < 2; ++ps) { const int row = (tid >> 4) + 32 * ps, chk = tid & 15;
            *(LAS u32x4*)(VT + (chk >> 2) * 4096 + (row >> 4) * 1024 + (row & 15) * 64 + (chk & 3) * 16) = P.v[ps]; }
        TSK(41);
        LDS_BAR();
        TSK(42);
        asm volatile("" : "+v"(tid)); lane = tid & 63;
        const int hi = lane >> 5, r32 = lane & 31;
        if (it + 1 < 4) m3_load(F, item + 1, tid, P, lds0 + RAW0);
        bf16_t* pr = PROJ + (row0 + (tid >> 3)) * LDP + h * 128 + (tid & 7) * 16;
        const u32x4 ob0 = *(const u32x4*)(pr + P_OB), ob1 = *(const u32x4*)(pr + P_OB + 8), zb0 = *(const u32x4*)(pr + P_ZB), zb1 = *(const u32x4*)(pr + P_ZB + 8);
        TSK(50);
        { const int t = tid >> 3, part = tid & 7; float a = 0.f;
#pragma unroll
          for (int k = 0; k < 2; ++k) { const int chk = 2 * part + k; const u32x4 w = *(LAS const u32x4*)(QT + t * 256 + ((chk ^ (t & 15)) << 4)); const LAS float* np = nst + chk * 8;
              a += bflo(w.x) * np[0] + bfhi(w.x) * np[1] + bflo(w.y) * np[2] + bfhi(w.y) * np[3] + bflo(w.z) * np[4] + bfhi(w.z) * np[5] + bflo(w.w) * np[6] + bfhi(w.w) * np[7]; }
          a += bperm(a, lane ^ 1); a += bperm(a, lane ^ 2); a += bperm(a, lane ^ 4);
          if (part == 0) qn[t] = a; }
        TSK(51);
        const int tb = wave & 1, eb = wave >> 1;
        const int tq = 32 * tb + r32;
        f32x16 p0, p1;
#pragma unroll
        for (int r = 0; r < 16; ++r) { p0[r] = 0.f; p1[r] = 0.f; }
#pragma unroll
        for (int hb = 0; hb < 2; ++hb) {
            bf16x8 qf[4], k0f[4], k1f[4];
#pragma unroll
            for (int j = 0; j < 4; ++j) { const int chk = 2 * (4 * hb + j) + hi;
                qf[j] = *(LAS const bf16x8*)(QT + tq * 256 + ((chk ^ (tq & 15)) << 4));
                k0f[j] = *(LAS const bf16x8*)(KT + r32 * 256 + ((chk ^ (r32 & 15)) << 4));
                k1f[j] = *(LAS const bf16x8*)(KT + (32 + r32) * 256 + ((chk ^ (r32 & 15)) << 4)); }
            SBAR();
#pragma unroll
            for (int j = 0; j < 4; ++j) { p0 = __builtin_amdgcn_mfma_f32_32x32x16_bf16(k0f[j], qf[j], p0, 0, 0, 0); p1 = __builtin_amdgcn_mfma_f32_32x32x16_bf16(k1f[j], qf[j], p1, 0, 0, 0); }
            SBAR();
        }
        TSK(52);
        const float mxt = mx[tq];
        float dsum = 0.f;
#pragma unroll
        for (int g = 0; g < 4; ++g) { const f32x4 g0 = *(LAS const f32x4*)(gs + 8 * g + 4 * hi), g1 = *(LAS const f32x4*)(gs + 32 + 8 * g + 4 * hi);
#pragma unroll
            for (int j = 0; j < 4; ++j) { const int r = 4 * g + j, s0 = 8 * g + 4 * hi + j;
                const float w0 = (s0 <= tq) ? ex2(g0[j] - mxt) * KSCALE : 0.f; p0[r] *= w0;
                const float w1 = (s0 + 32 <= tq) ? ex2(g1[j] - mxt) * KSCALE : 0.f; p1[r] *= w1;
                dsum += p0[r] + p1[r]; } }
        dsum = half_swap_add(dsum);
        u32x4 pw[4];
        pw[0] = (u32x4){cvtpk(p0[0], p0[1]), cvtpk(p0[2], p0[3]), cvtpk(p0[4], p0[5]), cvtpk(p0[6], p0[7])};
        pw[1] = (u32x4){cvtpk(p0[8], p0[9]), cvtpk(p0[10], p0[11]), cvtpk(p0[12], p0[13]), cvtpk(p0[14], p0[15])};
        pw[2] = (u32x4){cvtpk(p1[0], p1[1]), cvtpk(p1[2], p1[3]), cvtpk(p1[4], p1[5]), cvtpk(p1[6], p1[7])};
        pw[3] = (u32x4){cvtpk(p1[8], p1[9]), cvtpk(p1[10], p1[11]), cvtpk(p1[12], p1[13]), cvtpk(p1[14], p1[15])};
        TSK(53);
        const int trb = ((lane >> 4) & 1) * 32 + (lane & 3) * 8 + (4 * hi + ((lane & 15) >> 2)) * 64;
        f32x16 a1, a2;
#pragma unroll
        for (int r = 0; r < 16; ++r) { a1[r] = 0.f; a2[r] = 0.f; }
        { bf16x8 vf[4];
#pragma unroll
          for (int ks = 0; ks < 4; ++ks) vf[ks] = tr2(VT + eb * 4096 + ks * 1024 + trb);
          SBAR();
#pragma unroll
          for (int ks = 0; ks < 4; ++ks) a1 = __builtin_amdgcn_mfma_f32_32x32x16_bf16(__builtin_bit_cast(bf16x8, pw[ks]), vf[ks], a1, 0, 0, 0);
          SBAR(); }
        if (ch > 0) {
#pragma unroll
            for (int hb = 0; hb < 2; ++hb) {
                u32x4 qq[4]; bf16x8 cf[4];
#pragma unroll
                for (int j = 0; j < 4; ++j) { const int d0 = 4 * hb + j;
                    const u32x2 qa = *(LAS const u32x2*)(QT + tq * 256 + ((((2 * d0) ^ (tq & 15))) << 4) + 8 * hi), qb = *(LAS const u32x2*)(QT + tq * 256 + ((((2 * d0 + 1) ^ (tq & 15))) << 4) + 8 * hi);
                    qq[j] = (u32x4){qa.x, qa.y, qb.x, qb.y};
                    cf[j] = tr2(CT + eb * 8192 + d0 * 1024 + trb); }
                SBAR();
#pragma unroll
                for (int j = 0; j < 4; ++j) a2 = __builtin_amdgcn_mfma_f32_32x32x16_bf16(__builtin_bit_cast(bf16x8, qq[j]), cf[j], a2, 0, 0, 0);
                SBAR();
            }
        }
        TSK(43);
        LDS_BAR();
        if (it + 1 < 4) m3_load_c(F, item + 1, lane, lds0 + 49152);
        { const float den = dsum + wint[tq] * qn[tq]; const float hd = rcp(fmaxf(fabsf(den), dfl[tq]));
          if (hi == 0) wsf[r32] = hd; }
        asm volatile("s_waitcnt lgkmcnt(0)" ::: "memory");
#pragma unroll
        for (int g = 0; g < 4; ++g) { const f32x4 wi = *(LAS const f32x4*)(wint + 32 * tb + 8 * g + 4 * hi), hd4 = *(LAS const f32x4*)(wsf + 8 * g + 4 * hi);
#pragma unroll
            for (int j = 0; j < 4; ++j) { const int r = 4 * g + j, t = 32 * tb + 8 * g + 4 * hi + j;
                ST[t * 128 + 32 * eb + r32] = (a1[r] + wi[j] * a2[r]) * hd4[j]; } }
        LDS_BAR();
        TSK(44);
        { const int t = tid >> 3, part = tid & 7;
          float hv[16];
#pragma unroll
          for (int k = 0; k < 4; ++k) { const f32x4 v = *(LAS const f32x4*)(ST + t * 128 + part * 16 + 4 * k); hv[4 * k] = v[0]; hv[4 * k + 1] = v[1]; hv[4 * k + 2] = v[2]; hv[4 * k + 3] = v[3]; }
          const unsigned obw[8] = {ob0.x, ob0.y, ob0.z, ob0.w, ob1.x, ob1.y, ob1.z, ob1.w}, zbw[8] = {zb0.x, zb0.y, zb0.z, zb0.w, zb1.x, zb1.y, zb1.z, zb1.w};
          float ss = 0.f;
#pragma unroll
          for (int k = 0; k < 8; ++k) { hv[2 * k] *= sigm(bflo(obw[k])); hv[2 * k + 1] *= sigm(bfhi(obw[k])); ss += hv[2 * k] * hv[2 * k] + hv[2 * k + 1] * hv[2 * k + 1]; }
          ss += bperm(ss, lane ^ 1); ss += bperm(ss, lane ^ 2); ss += bperm(ss, lane ^ 4);
          const float rs = rsqrtf(ss * (1.f / 128.f) + EPS);
          unsigned ow[8];
#pragma unroll
          for (int k = 0; k < 8; ++k) { const f32x2 nb2 = *(LAS const f32x2*)(nbL + part * 16 + 2 * k);
              ow[k] = cvtpk(hv[2 * k] * rs * nb2[0] * silu(bflo(zbw[k])), hv[2 * k + 1] * rs * nb2[1] * silu(bfhi(zbw[k]))); }
          asm volatile("s_waitcnt vmcnt(0)" ::: "memory");

#ifdef HO_AMG
          st16_wt(F.ws, (size_t)((unsigned char*)(pr + P_YB) - F.ws), (u32x4){ow[0], ow[1], ow[2], ow[3]}); st16_wt(F.ws, (size_t)((unsigned char*)(pr + P_YB + 8) - F.ws), (u32x4){ow[4], ow[5], ow[6], ow[7]}); }
#else
          *(u32x4*)(pr + P_YB) = (u32x4){ow[0], ow[1], ow[2], ow[3]}; *(u32x4*)(pr + P_YB + 8) = (u32x4){ow[4], ow[5], ow[6], ow[7]}; }
#endif

        TSK(45);
        LDS_BAR();
    }
    asm volatile("s_waitcnt vmcnt(0)" ::: "memory");
}

struct M3PreD { u32x4 v[2]; float ig, fg, mj, nst, cw0, cw1, nb; };
__device__ __forceinline__ void m3_load_d(Frame& F, int l, int item, int tid, M3PreD& P, unsigned raw_lds) {
    const int lane = tid & 63, wave = F.wave;
    const int bh = item >> 6, ch = item & 63, b = bh >> 2, h = bh & 3; const long row0 = (long)b * SEQ + ch * 64;
    const bf16_t* PROJ = (const bf16_t*)(F.ws + WS_PROJ);
    { const bf16_t* rb = PROJ + (row0 - 3) * LDP + h * 128;
      const unsigned lo = (unsigned)((lane >> 4) * LDP + (lane & 15) * 8) * 2u;
      for (int pc = wave; pc < 34; pc += NWAVES) { const int tsr = pc >= 17 ? 1 : 0, pp = pc - 17 * tsr;
          glds16s(rb, lo + (unsigned)((4 * pp) * LDP + (tsr ? P_KB : P_QB)) * 2u, (unsigned)__builtin_amdgcn_readfirstlane(raw_lds + tsr * 17408 + pp * 1024)); } }
#pragma unroll
    for (int ps = 0; ps < 2; ++ps) { const int row = (tid >> 4) + 32 * ps, chk = tid & 15; P.v[ps] = *(const u32x4*)(PROJ + (row0 + row) * LDP + P_VB + h * 128 + chk * 8); }
    P.ig = 0.f; P.fg = 0.f; P.mj = 0.f; P.nst = 0.f;
    if (wave == 0) { const float* GATES = (const float*)(F.ws + WS_GATES); const float* gb = ARGP(4) + l * 8 + h;
        P.ig = GATES[(row0 + lane) * 8 + h] + gb[0]; P.fg = GATES[(row0 + lane) * 8 + 4 + h] + gb[4]; P.mj = ((const float*)(F.ws + WS_MSC) + 2048)[item]; }
    else if (wave <= 2) { if (ch > 0) P.nst = ((const float*)(F.ws + WS_DN))[(size_t)(item - 1) * 128 + (tid - 64)]; }
    { const float* cw = ARGP(5) + (size_t)l * 4096 + h * 128; const int k = (tid >> 7) & 3, dd = tid & 127; P.cw0 = cw[k * 1024 + dd]; P.cw1 = cw[k * 1024 + 512 + dd]; }
    P.nb = 0.f; if (tid < 128) P.nb = ARGP(8)[l * 512 + h * 128 + tid];
}
__device__ __forceinline__ void mlstm3_dyn(Frame& F, int l) {
    int tid0 = F.tid; asm volatile("" : "+v"(tid0));
    const int wave = F.wave;
    bf16_t* PROJ = (bf16_t*)(F.ws + WS_PROJ);
    LAS unsigned char* QT = F.lds; LAS unsigned char* KT = F.lds + 16384; LAS unsigned char* VT = F.lds + 32768; LAS unsigned char* CT = F.lds + 49152;
    LAS float* ST = (LAS float*)(F.lds);
    constexpr int RAW0 = 81920;
    LAS float* SC = (LAS float*)(F.lds + 139264);
    LAS float* gs = SC; LAS float* mx = SC + 64; LAS float* wint = SC + 128; LAS float* dfl = SC + 192; LAS float* qn = SC + 256; LAS float* nst = SC + 320;
    LAS float* nbL0 = SC + 448; LAS float* cwL = SC + 576;
    LAS float* wsf = (LAS float*)(F.lds + WSF_OFF) + wave * 64;
    const unsigned lds0 = (unsigned)(uintptr_t)F.lds;
    volatile LAS unsigned* MISCq = (volatile LAS unsigned*)(F.lds + MISC_OFF);
    unsigned* Q = (unsigned*)(F.ws + WS_CTL) + CW_M3Q + 32 * l;
#ifdef M3_STATIC2
    int cur = F.vcu, nxt = F.G + F.vcu;
    const unsigned qbase = 2u * (unsigned)F.G;
#else
    const unsigned qbase = 0u;
#ifdef HO_M123
    unsigned c0_ = 0u, c1_ = 0u; if (is_t0(wave)) { c0_ = xb_add(Q, 1u); c1_ = xb_add(Q, 1u); }
#ifdef HO_M3HIDE
    if (MISCq[27] == 0u)
#endif
    ho_wait<256>(F, CW_F2 + 256 * l);
    if (is_t0(wave)) { MISCq[24] = c0_; MISCq[25] = c1_; }
    __syncthreads();
#else
    if (is_t0(wave)) { const unsigned c0 = xb_add(Q, 1u), c1 = xb_add(Q, 1u); MISCq[24] = c0; MISCq[25] = c1; }
    __syncthreads();
#endif
    int cur = __builtin_amdgcn_readfirstlane((int)MISCq[24]), nxt = __builtin_amdgcn_readfirstlane((int)MISCq[25]);
    if (cur >= 1024) return;
#endif
    M3PreD P;
    m3_load_d(F, l, cur, tid0, P, lds0 + RAW0);
    m3_load_c(F, cur, tid0 & 63, lds0 + 49152);
    cwL[tid0] = P.cw0; cwL[tid0 + 512] = P.cw1; if (tid0 < 128) nbL0[tid0] = P.nb;
    WG_BAR();
    int par = 0;
#pragma unroll 1
    for (;;) {
        const int item = cur, ch = item & 63, h = (item >> 6) & 3; const long row0 = (long)(item >> 8) * SEQ + ch * 64;
        LAS float* nbL = nbL0 + par * 1152;
        int tid = tid0; asm volatile("" : "+v"(tid));
        int lane = tid & 63, cp = tid & 63, rg = tid >> 6;
        TSK(40);
        if (wave == 0) {
            const float bs = wave_prefix_sum(logsig(P.fg), lane);
            const float g = P.ig - bs, pm = wave_prefix_max(g, lane), mxv = fmaxf(P.mj, pm);
            gs[lane] = g * LOG2E; mx[lane] = mxv * LOG2E; wint[lane] = fexp(P.mj - mxv); dfl[lane] = fexp(-(bs + mxv));
        } else if (wave <= 2) nst[tid - 64] = P.nst;
        { float y[8][2];
          conv_lds(F.lds + RAW0, ch == 0, cp, rg, cwL, y);
#pragma unroll
          for (int r = 0; r < 8; ++r) { const int s = 8 * rg + r, d = 2 * cp; *(LAS unsigned*)(QT + s * 256 + ((((d >> 3) ^ (s & 15))) << 4) + (d & 7) * 2) = cvtpk(y[r][0], y[r][1]); }
          conv_lds(F.lds + RAW0 + 17408, ch == 0, cp, rg, cwL + 512, y);
#pragma unroll
          for (int r = 0; r < 8; ++r) { const int s = 8 * rg + r, d = 2 * cp; *(LAS unsigned*)(KT + s * 256 + ((((d >> 3) ^ (s & 15))) << 4) + (d & 7) * 2) = cvtpk(y[r][0], y[r][1]); } }
#pragma unroll
        for (int ps = 0; ps < 2; ++ps) { const int row = (tid >> 4) + 32 * ps, chk = tid & 15;
            *(LAS u32x4*)(VT + (chk >> 2) * 4096 + (row >> 4) * 1024 + (row & 15) * 64 + (chk & 3) * 16) = P.v[ps]; }
        TSK(41);
        LDS_BAR();
        TSK(42);
        asm volatile("" : "+v"(tid)); lane = tid & 63;
        const int hi = lane >> 5, r32 = lane & 31;
        if (nxt < 1024) m3_load_d(F, l, nxt, tid, P, lds0 + RAW0);
        unsigned claim = 0u; if (is_t0(wave)) claim = xb_add(Q, 1u) + qbase;
        bf16_t* pr = PROJ + (row0 + (tid >> 3)) * LDP + h * 128 + (tid & 7) * 16;
        const u32x4 ob0 = *(const u32x4*)(pr + P_OB), ob1 = *(const u32x4*)(pr + P_OB + 8), zb0 = *(const u32x4*)(pr + P_ZB), zb1 = *(const u32x4*)(pr + P_ZB + 8);
        TSK(50);
        { const int t = tid >> 3, part = tid & 7; float a = 0.f;
#pragma unroll
          for (int k = 0; k < 2; ++k) { const int chk = 2 * part + k; const u32x4 w = *(LAS const u32x4*)(QT + t * 256 + ((chk ^ (t & 15)) << 4)); const LAS float* np = nst + chk * 8;
              a += bflo(w.x) * np[0] + bfhi(w.x) * np[1] + bflo(w.y) * np[2] + bfhi(w.y) * np[3] + bflo(w.z) * np[4] + bfhi(w.z) * np[5] + bflo(w.w) * np[6] + bfhi(w.w) * np[7]; }
          a += bperm(a, lane ^ 1); a += bperm(a, lane ^ 2); a += bperm(a, lane ^ 4);
          if (part == 0) qn[t] = a; }
        TSK(51);
        const int tb = wave & 1, eb = wave >> 1;
        const int tq = 32 * tb + r32;
        f32x16 p0, p1;
#pragma unroll
        for (int r = 0; r < 16; ++r) { p0[r] = 0.f; p1[r] = 0.f; }
#pragma unroll
        for (int hb = 0; hb < 2; ++hb) {
            bf16x8 qf[4], k0f[4], k1f[4];
#pragma unroll
            for (int j = 0; j < 4; ++j) { const int chk = 2 * (4 * hb + j) + hi;
                qf[j] = *(LAS const bf16x8*)(QT + tq * 256 + ((chk ^ (tq & 15)) << 4));
                k0f[j] = *(LAS const bf16x8*)(KT + r32 * 256 + ((chk ^ (r32 & 15)) << 4));
                k1f[j] = *(LAS const bf16x8*)(KT + (32 + r32) * 256 + ((chk ^ (r32 & 15)) << 4)); }
            SBAR();
#pragma unroll
            for (int j = 0; j < 4; ++j) { p0 = __builtin_amdgcn_mfma_f32_32x32x16_bf16(k0f[j], qf[j], p0, 0, 0, 0); p1 = __builtin_amdgcn_mfma_f32_32x32x16_bf16(k1f[j], qf[j], p1, 0, 0, 0); }
            SBAR();
        }
        TSK(52);
        const float mxt = mx[tq];
        float dsum = 0.f;
#pragma unroll
        for (int g = 0; g < 4; ++g) { const f32x4 g0 = *(LAS const f32x4*)(gs + 8 * g + 4 * hi), g1 = *(LAS const f32x4*)(gs + 32 + 8 * g + 4 * hi);
#pragma unroll
            for (int j = 0; j < 4; ++j) { const int r = 4 * g + j, s0 = 8 * g + 4 * hi + j;
                const float w0 = (s0 <= tq) ? ex2(g0[j] - mxt) * KSCALE : 0.f; p0[r] *= w0;
                const float w1 = (s0 + 32 <= tq) ? ex2(g1[j] - mxt) * KSCALE : 0.f; p1[r] *= w1;
                dsum += p0[r] + p1[r]; } }
        dsum = half_swap_add(dsum);
        u32x4 pw[4];
        pw[0] = (u32x4){cvtpk(p0[0], p0[1]), cvtpk(p0[2], p0[3]), cvtpk(p0[4], p0[5]), cvtpk(p0[6], p0[7])};
        pw[1] = (u32x4){cvtpk(p0[8], p0[9]), cvtpk(p0[10], p0[11]), cvtpk(p0[12], p0[13]), cvtpk(p0[14], p0[15])};
        pw[2] = (u32x4){cvtpk(p1[0], p1[1]), cvtpk(p1[2], p1[3]), cvtpk(p1[4], p1[5]), cvtpk(p1[6], p1[7])};
        pw[3] = (u32x4){cvtpk(p1[8], p1[9]), cvtpk(p1[10], p1[11]), cvtpk(p1[12], p1[13]), cvtpk(p1[14], p1[15])};
        TSK(53);
        const int trb = ((lane >> 4) & 1) * 32 + (lane & 3) * 8 + (4 * hi + ((lane & 15) >> 2)) * 64;
        f32x16 a1, a2;
#pragma unroll
        for (int r = 0; r < 16; ++r) { a1[r] = 0.f; a2[r] = 0.f; }
        { bf16x8 vf[4];
#pragma unroll
          for (int ks = 0; ks < 4; ++ks) vf[ks] = tr2(VT + eb * 4096 + ks * 1024 + trb);
          SBAR();
#pragma unroll
          for (int ks = 0; ks < 4; ++ks) a1 = __builtin_amdgcn_mfma_f32_32x32x16_bf16(__builtin_bit_cast(bf16x8, pw[ks]), vf[ks], a1, 0, 0, 0);
          SBAR(); }
        if (ch > 0) {
#pragma unroll
            for (int hb = 0; hb < 2; ++hb) {
                u32x4 qq[4]; bf16x8 cf[4];
#pragma unroll
                for (int j = 0; j < 4; ++j) { const int d0 = 4 * hb + j;
                    const u32x2 qa = *(LAS const u32x2*)(QT + tq * 256 + ((((2 * d0) ^ (tq & 15))) << 4) + 8 * hi), qb = *(LAS const u32x2*)(QT + tq * 256 + ((((2 * d0 + 1) ^ (tq & 15))) << 4) + 8 * hi);
                    qq[j] = (u32x4){qa.x, qa.y, qb.x, qb.y};
                    cf[j] = tr2(CT + eb * 8192 + d0 * 1024 + trb); }
                SBAR();
#pragma unroll
                for (int j = 0; j < 4; ++j) a2 = __builtin_amdgcn_mfma_f32_32x32x16_bf16(__builtin_bit_cast(bf16x8, qq[j]), cf[j], a2, 0, 0, 0);
                SBAR();
            }
        }
        TSK(43);
        LDS_BAR();
        if (nxt < 1024) m3_load_c(F, nxt, lane, lds0 + 49152);
        { const float den = dsum + wint[tq] * qn[tq]; const float hd = rcp(fmaxf(fabsf(den), dfl[tq]));
          if (hi == 0) wsf[r32] = hd; }
        asm volatile("s_waitcnt lgkmcnt(0)" ::: "memory");
#pragma unroll
        for (int g = 0; g < 4; ++g) { const f32x4 wi = *(LAS const f32x4*)(wint + 32 * tb + 8 * g + 4 * hi), hd4 = *(LAS const f32x4*)(wsf + 8 * g + 4 * hi);
#pragma unroll
            for (int j = 0; j < 4; ++j) { const int r = 4 * g + j, t = 32 * tb + 8 * g + 4 * hi + j;
                ST[t * 128 + 32 * eb + r32] = (a1[r] + wi[j] * a2[r]) * hd4[j]; } }
        LDS_BAR();
        TSK(44);
        { const int t = tid >> 3, part = tid & 7;
          float hv[16];
#pragma unroll
          for (int k = 0; k < 4; ++k) { const f32x4 v = *(LAS const f32x4*)(ST + t * 128 + part * 16 + 4 * k); hv[4 * k] = v[0]; hv[4 * k + 1] = v[1]; hv[4 * k + 2] = v[2]; hv[4 * k + 3] = v[3]; }
          const unsigned obw[8] = {ob0.x, ob0.y, ob0.z, ob0.w, ob1.x, ob1.y, ob1.z, ob1.w}, zbw[8] = {zb0.x, zb0.y, zb0.z, zb0.w, zb1.x, zb1.y, zb1.z, zb1.w};
          float ss = 0.f;
#pragma unroll
          for (int k = 0; k < 8; ++k) { hv[2 * k] *= sigm(bflo(obw[k])); hv[2 * k + 1] *= sigm(bfhi(obw[k])); ss += hv[2 * k] * hv[2 * k] + hv[2 * k + 1] * hv[2 * k + 1]; }
          ss += bperm(ss, lane ^ 1); ss += bperm(ss, lane ^ 2); ss += bperm(ss, lane ^ 4);
          const float rs = rsqrtf(ss * (1.f / 128.f) + EPS);
          unsigned ow[8];
#pragma unroll
          for (int k = 0; k < 8; ++k) { const f32x2 nb2 = *(LAS const f32x2*)(nbL + part * 16 + 2 * k);
              ow[k] = cvtpk(hv[2 * k] * rs * nb2[0] * silu(bflo(zbw[k])), hv[2 * k + 1] * rs * nb2[1] * silu(bfhi(zbw[k]))); }
          asm volatile("s_waitcnt vmcnt(0)" ::: "memory");

#ifdef HO_AMG
          st16_wt(F.ws, (size_t)((unsigned char*)(pr + P_YB) - F.ws), (u32x4){ow[0], ow[1], ow[2], ow[3]}); st16_wt(F.ws, (size_t)((unsigned char*)(pr + P_YB + 8) - F.ws), (u32x4){ow[4], ow[5], ow[6], ow[7]}); }
#else
          *(u32x4*)(pr + P_YB) = (u32x4){ow[0], ow[1], ow[2], ow[3]}; *(u32x4*)(pr + P_YB + 8) = (u32x4){ow[4], ow[5], ow[6], ow[7]}; }
#endif

        TSK(45);
        if (nxt < 1024) { cwL[tid] = P.cw0; cwL[tid + 512] = P.cw1; if (tid < 128) nbL0[(par ^ 1) * 1152 + tid] = P.nb; }
        if (is_t0(wave)) MISCq[24] = claim;
        LDS_BAR();
        cur = nxt; nxt = __builtin_amdgcn_readfirstlane((int)MISCq[24]); par ^= 1;
        if (cur >= 1024) break;
    }
    asm volatile("s_waitcnt vmcnt(0)" ::: "memory");
}
constexpr int NPHASES = 17;
#ifndef MK_NT_OUT
#define MK_NT_OUT 0
#endif
#ifndef MK_NT_PROJ
#define MK_NT_PROJ 0
#endif
#ifndef MK_TOFF
#define MK_TOFF 0
#endif
#ifndef MK_ONLY
#define MK_ONLY -1
#endif
#define EN(k) (MK_ONLY < 0 || MK_ONLY == (k))
struct Args { const float* in[12]; float* out; unsigned char* ws; int ph_lo, ph_hi; };

__global__ void __launch_bounds__(NTHREADS, 2) fwd_kernel(Args args) {
    extern __shared__ __attribute__((aligned(16))) unsigned char lds_raw[];
    Frame F;
    F.lds = (LAS unsigned char*)lds_raw;
    F.wave = __builtin_amdgcn_readfirstlane(threadIdx.x >> 6); F.tid = 0; F.lane = 0;
    F.G = gridDim.x; { const int bx = blockIdx.x; F.vcu = (F.G % 8 == 0) ? (bx % 8) * (F.G / 8) + bx / 8 : bx; }
    F.ws = args.ws;
    volatile LAS unsigned* MISC = (volatile LAS unsigned*)(F.lds + MISC_OFF);
    for (int u = threadIdx.x; u < (LDS_BYTES - LDSCTL_OFF) / 4; u += NTHREADS) ((LAS unsigned*)(F.lds + LDSCTL_OFF))[u] = 0u;
    __syncthreads();
#if MK_LAUNCH_MODE == 1
    constexpr int lo = 0, hi = NPHASES; constexpr bool use_bar = true;
#else
    const int lo = args.ph_lo, hi = args.ph_hi;
    const bool use_bar = (hi - lo) > 1;
#endif
    XcdBarrier bar; bar.bar = (unsigned*)(F.ws + WS_CTL) + CW_BAR; bar.x = 0; bar.st = nullptr; bar.wave = F.wave;
    if (use_bar) bar = xcd_barrier_post((unsigned*)(F.ws + WS_CTL) + CW_BAR, MISC + 8, F.wave);
#define RETID() do { int l_ = lane_now(); asm volatile("" : "+v"(l_)); F.lane = l_; F.tid = F.wave * 64 + l_; { int v_ = F.vcu, w_ = F.wave; GAS unsigned char* ws_ = (GAS unsigned char*)F.ws; asm volatile("" : "+s"(v_), "+s"(w_), "+s"(ws_)); F.vcu = v_; F.wave = w_; F.ws = (unsigned char*)ws_; } } while (0)
#define IN(k) (lo <= (k) && (k) < hi)
#ifdef MK_TPROBE
    if (is_t0(F.wave)) { const unsigned long long t0_ = __builtin_amdgcn_s_memrealtime(); MISC[16] = (unsigned)t0_; MISC[17] = (unsigned)(t0_ >> 32); MISC[18] = 0u; }
#define TSTAMP(kind_) do { if (is_t0(F.wave)) { const unsigned long long tn_ = __builtin_amdgcn_s_memrealtime(); const unsigned long long tp_ = ((unsigned long long)MISC[17] << 32) | MISC[16]; \
        if ((kind_) == MK_TPROBE || MK_TPROBE == 99) MISC[18] = __float_as_uint(__uint_as_float(MISC[18]) + (float)(tn_ - tp_) * 0.01f); MISC[16] = (unsigned)tn_; MISC[17] = (unsigned)(tn_ >> 32); } } while (0)
#define SEAM(k) do { if (IN((k) + 1)) xcd_barrier(bar); TSTAMP(((k) == 0) ? 0 : (((k) - 1) % 8) + 1); } while (0)
#else
#define SEAM(k) do { if (IN((k) + 1)) xcd_barrier(bar); } while (0)
#endif

#if defined(HO_P0) && defined(HO_M123) && MK_LAUNCH_MODE == 1
    if (EN(0) && IN(0)) { RETID(); p0_weights(F, 0, true); RETID(); norm_pass<0>(F, ARGP(0), nullptr, nullptr, ARGP(1), ARGP(3));
        ho_publish(F, 8192 + F.vcu);
        RETID(); p0_weights(F, 1, false);
        ho_wait<256>(F, 8192); }
#else
    if (EN(0) && IN(0)) { RETID(); p0_weights(F);
#ifdef MK_TPROBE
        __syncthreads(); TSTAMP(30);
#endif
        RETID(); norm_pass<0>(F, ARGP(0), nullptr, nullptr, ARGP(1), ARGP(3)); SEAM(0); }
#endif

    for (int l = 0; l < 2; ++l) {
        const int pb = 1 + 8 * l;
#define PROJ ((bf16_t*)(F.ws + WS_PROJ))
#define HN ((bf16_t*)(F.ws + WS_HN))
#define WIN ((const bf16_t*)(F.ws + WS_WIN) + (size_t)l * NL * D)
#define WAB ((const bf16_t*)(F.ws + WS_WAB) + (size_t)l * D * D)
#define WOUT ((const bf16_t*)(F.ws + WS_WOUT) + (size_t)l * D * D)
        if (EN(1) && IN(pb + 0)) { RETID();
            Gemm g{HN, WIN, M, NLA, D, D}; StaticOrder S; S.init(M, NLA, F.G, (int)blockIdx.x);
            Epi<0> E{PROJ, LDP, nullptr, nullptr}; E.nts = MK_NT_PROJ;
#ifdef G1A_WT
            E.wt = 1;
#endif
#ifdef MK_WIDE
            g.wide = 1; E.wide = 1;
#endif
#if MK_LAUNCH_MODE == 1 && !defined(MK_NO_HALFM)
            S.max_i = 4;
#ifdef MK_HALF_STAGGER
            const int hfirst = ((int)blockIdx.x >> 3) & 1;
#pragma unroll 1
            for (int pass = 0; pass < 2; ++pass) {
                RETID();
                if ((pass == 0) == (hfirst != 0)) { HalfOrder H; H.init(M, NLA, F.G, (int)blockIdx.x, 4); Epi<0> EH{PROJ, LDP, nullptr, nullptr}; EH.half = 1; EH.nts = MK_NT_PROJ; EH.wide = E.wide; EH.wt = E.wt;
                    gemm_phase<Epi<0>, false, HalfOrder, true>(F.lds, g, H, EH, F.wave); }
                else gemm_phase<Epi<0>, true, StaticOrder>(F.lds, g, S, E, F.wave);
            }
#else
            gemm_phase<Epi<0>, true, StaticOrder>(F.lds, g, S, E, F.wave);
#if defined(HO_G1EARLY) && defined(HO_G1)
            ho_publish(F, (l == 0 ? 768 : 1664) + (int)blockIdx.x);
#endif
            { RETID(); HalfOrder H; H.init(M, NLA, F.G, (int)blockIdx.x, 4); Epi<0> EH{PROJ, LDP, nullptr, nullptr}; EH.half = 1; EH.nts = MK_NT_PROJ; EH.wide = E.wide; EH.wt = E.wt;
              gemm_phase<Epi<0>, false, HalfOrder, true>(F.lds, g, H, EH, F.wave); }
#endif
#else
            gemm_phase<Epi<0>, true, StaticOrder>(F.lds, g, S, E, F.wave);
#endif
#if defined(HO_G1) && MK_LAUNCH_MODE == 1 && !defined(MK_NO_HALFM)
            ho_publish(F, CW_G1 + 256 * l + (int)blockIdx.x);
#else
            SEAM(pb + 0);
#endif
        }
#ifdef MK_REORDER
#if defined(HO_M123) && MK_LAUNCH_MODE == 1
#ifdef HO_G1
        if (EN(2) && IN(pb + 1)) { RETID(); ho_wait_m1(F, l); RETID(); mlstm1_run(F, l, F.vcu * 4); }
#else
        if (EN(2) && IN(pb + 1)) { RETID(); mlstm1_run(F, l, F.vcu * 4); }
#endif
        if (EN(3) && IN(pb + 2)) { RETID(); mlstm_scan(F, l); }
#define HO_M123_ACTIVE
#endif
#ifndef HO_M123_ACTIVE
        if (EN(2) && IN(pb + 1)) { RETID(); mlstm1_run(F, l, F.vcu * 4); SEAM(pb + 1); }
#ifdef AT_PREFETCH
        if (EN(3) && IN(pb + 2)) { RETID(); { const int bh = F.vcu >> 4, s = F.vcu & 15; attn_prefetch(F, bh >> 2, bh & 3, 31 - s); } RETID(); mlstm_scan(F); SEAM(pb + 2); }
#else
        if (EN(3) && IN(pb + 2)) { RETID(); mlstm_scan(F); SEAM(pb + 2); }
#endif
#endif
        if (EN(4) && IN(pb + 3)) { RETID();
#ifdef MK_M3_FIRST
            mlstm3_run(F, l, F.vcu * 4); RETID();
#endif
#if defined(HO_G1) && MK_LAUNCH_MODE == 1
#ifdef HO_NOACQ
            if (((volatile LAS unsigned*)(F.lds + MISC_OFF))[26] == 0u) ho_wait<256, false>(F, CW_G1 + 256 * l);
#else
            if (((volatile LAS unsigned*)(F.lds + MISC_OFF))[26] == 0u) ho_wait<256>(F, CW_G1 + 256 * l);
#endif
            RETID();
#endif
            { const int bh = F.vcu >> 4, s = F.vcu & 15;
#ifdef AT_PREFETCH
              attn_unit<8, true>(F, l, bh >> 2, bh & 3, 31 - s); RETID(); attn_unit<8, false>(F, l, bh >> 2, bh & 3, s); }
#else
#if defined(HO_M3HIDE) && defined(HO_M123) && MK_LAUNCH_MODE == 1
              attn_unit<8>(F, l, bh >> 2, bh & 3, 31 - s);
              if (F.wave == 0) { const int ln = lane_now(); unsigned* ps = (unsigned*)(F.ws + WS_CTL) + CW_F2 + 256 * l; bool oks = true;
#pragma unroll
                  for (int k = 0; k < 4; ++k) oks = oks && (xb_ld(ps + ln + 64 * k) != 0u);
                  const bool alls = __all(oks);
                  if (ln == 0) { if (alls) __builtin_amdgcn_fence(__ATOMIC_ACQUIRE, "agent"); ((volatile LAS unsigned*)(F.lds + MISC_OFF))[27] = alls ? 1u : 0u; } }
              RETID(); attn_unit<8>(F, l, bh >> 2, bh & 3, s); }
#else
              for (int k = 0; k < 2; ++k) attn_unit<8>(F, l, bh >> 2, bh & 3, k == 0 ? 31 - s : s); }
#endif
#endif
#ifdef MK_TPROBE
            TSTAMP(20);
#endif
#ifndef MK_M3_FIRST
#ifdef MK_M3_DYN
            RETID(); mlstm3_dyn(F, l);
#else
            RETID(); mlstm3_run(F, l, F.vcu * 4);
#endif
#endif
#if defined(HO_AMG) && defined(HO_M123) && defined(MK_M3_DYN) && MK_LAUNCH_MODE == 1
            ho_publish(F, CW_AM + 256 * l + F.vcu);
            if (is_t0(F.wave)) __builtin_amdgcn_fence(__ATOMIC_ACQUIRE, "agent");
#define HO_AMG_ACTIVE
            }
#else
            SEAM(pb + 3); }
#endif
#else
        if (EN(2) && IN(pb + 1)) { RETID();
#ifndef MK_NO_ML1
            mlstm1_run(F, l, F.vcu * 4);
#endif
#ifdef MK_TPROBE
            TSTAMP(20);
#endif
#ifndef MK_NO_ATT
            const int bh = F.vcu >> 4, s = F.vcu & 15;
            for (int k = 0; k < 2; ++k) attn_unit<8>(F, l, bh >> 2, bh & 3, k == 0 ? 31 - s : s);
#endif
#ifdef MK_TPROBE
            TSTAMP(21);
#endif
            SEAM(pb + 1);
        }
        if (EN(3) && IN(pb + 2)) { RETID(); mlstm_scan(F); SEAM(pb + 2); }
        if (EN(4) && IN(pb + 3)) { RETID(); mlstm3_run(F, l, F.vcu * 4); SEAM(pb + 3); }
#endif
        if (EN(5) && IN(pb + 4)) { RETID();
            Gemm g{HN, WIN + (size_t)NLA * D, M, 2048, D, D}; PairedOrder S; S.init(M, D, F.G, (int)blockIdx.x);
            Epi<1> E{PROJ + P_SGA, LDP, nullptr, PROJ + P_SGB};
#ifdef HO_AMG_ACTIVE
            { AllAM hk{F.ws, CW_AM + 256 * l}; gemm_phase<Epi<1>, true, PairedOrder, false, AllAM>(F.lds, g, S, E, F.wave, hk); }
#else
            gemm_phase<Epi<1>, true, PairedOrder>(F.lds, g, S, E, F.wave);
#endif
#if MK_LAUNCH_MODE == 1
            asm volatile("s_waitcnt vmcnt(0)" ::: "memory"); __syncthreads();
#ifndef NO_HANDOVER_FENCE
            if (is_t0(F.wave)) { __builtin_amdgcn_fence(__ATOMIC_ACQUIRE, "agent"); asm volatile("s_waitcnt vmcnt(0)" ::: "memory"); }
#endif
            __syncthreads();
#ifdef MK_TPROBE
            TSTAMP(5);
#endif
#else
            SEAM(pb + 4);
#endif
        }
        if (EN(6) && IN(pb + 5)) { RETID();
            Gemm g{PROJ + P_YA, WAB, M, D, D, LDP}; StaticOrder S; S.init(M, D, F.G, (int)blockIdx.x); g.ajump = (P_YB - 512) * 2;
            Epi<2> E{PROJ + P_MG, LDP, PROJ + P_SGA, PROJ + P_SGB};
#if defined(HO_G23) && MK_LAUNCH_MODE == 1
            E.wt = 1;
            gemm_phase<Epi<2>, false, StaticOrder>(F.lds, g, S, E, F.wave);
            { Unit u0; if (S.next(0, u0) && is_t0(F.wave)) __hip_atomic_store((unsigned*)(F.ws + WS_CTL) + CW_PANEL2 + 256 * l + 4 * u0.pm + u0.pn, 1u, __ATOMIC_RELAXED, __HIP_MEMORY_SCOPE_AGENT); }
#else
            gemm_phase<Epi<2>, false, StaticOrder>(F.lds, g, S, E, F.wave);
            SEAM(pb + 5);
#endif
        }
        if (EN(7) && IN(pb + 6)) { RETID();
            Gemm g{PROJ + P_MG, WOUT, M, D, D, LDP}; StaticOrder S; S.init(M, D, F.G, (int)blockIdx.x);
            Epi<0> E{PROJ + P_OUT, LDP, nullptr, nullptr}; E.nts = MK_NT_OUT;
#ifdef MK_WIDE
            g.wide = 1; E.wide = 1;
#endif
#if defined(HO_G23) && MK_LAUNCH_MODE == 1
            { Unit u0; if (S.next(0, u0)) { if (F.wave == 0) { const int ln = lane_now();
                  unsigned* pf = (unsigned*)(F.ws + WS_CTL) + CW_PANEL2 + 256 * l + 4 * u0.pm + (ln & 3); unsigned sp_ = 0;
                  while (!__all(xb_ld(pf) != 0u)) { __builtin_amdgcn_s_sleep(1); if (++sp_ > XB_SPIN_CAP) break; }
#ifndef HO_NOACQ
                  if (ln == 0) { __builtin_amdgcn_fence(__ATOMIC_ACQUIRE, "agent"); asm volatile("s_waitcnt vmcnt(0)" ::: "memory"); }
#endif
                  }
              __syncthreads(); } }
#endif
#if defined(HO_G3N) && MK_LAUNCH_MODE == 1
            E.wt = 1;
            gemm_phase<Epi<0>, false, StaticOrder>(F.lds, g, S, E, F.wave);
            { Unit u0; if (S.next(0, u0) && is_t0(F.wave)) __hip_atomic_store((unsigned*)(F.ws + WS_CTL) + CW_PANEL + 512 * l + 4 * u0.pm + u0.pn, 1u, __ATOMIC_RELAXED, __HIP_MEMORY_SCOPE_AGENT); }
#else
            gemm_phase<Epi<0>, false, StaticOrder>(F.lds, g, S, E, F.wave);
            SEAM(pb + 6);
#endif
        }
        if (EN(8) && IN(pb + 7)) { RETID();
            int rbase = -1, wword = -1;
#if defined(HO_G3N) && MK_LAUNCH_MODE == 1
            { StaticOrder S; S.init(M, D, F.G, (int)blockIdx.x); Unit u0; if (S.next(0, u0)) { rbase = 256 * u0.pm + 64 * u0.pn; wword = CW_PANEL + 512 * l + 4 * u0.pm; } }
            RETID();
#endif
            if (l == 0) { norm_pass<1>(F, ARGP(0), ARGO(), ARGP(2), ARGP(1) + D, ARGP(3) + (size_t)D * NINR, rbase, wword); SEAM(pb + 7); }
            else {
#ifdef MK_XPROBE
                { const int gw = F.vcu * NWAVES + F.wave; for (int m = gw; m < M; m += F.G * NWAVES) for (int j = 0; j < 4; ++j) *((f32x4*)(ARGO() + (size_t)m * D) + F.lane + 64 * j) = *((const f32x4*)(ARGP(0) + (size_t)m * D) + F.lane + 64 * j); }
#else
                norm_pass<2>(F, ARGO(), ARGO(), ARGP(2) + D, nullptr, nullptr, rbase, wword);
#endif
#ifdef MK_TPROBE
                __syncthreads(); TSTAMP(8);
                if (blockIdx.x == 0 && is_t0(F.wave)) { asm volatile("s_waitcnt vmcnt(0)" ::: "memory"); ARGO()[0] = (MK_TPROBE == 99) ? (__uint_as_float(MISC[18]) - 1000.f) * 0.1f : rintf((__uint_as_float(MISC[18]) - (float)MK_TOFF) * 0.5f) * 2.f; }
#endif
            }
        }
    }
#undef PROJ
#undef HN
#undef WIN
#undef WAB
#undef WOUT
#undef IN
#undef SEAM
}

static int g_grid = 0;
static void launch_all(void* const* d_in, void* d_out, void* d_ws, hipStream_t stream, int n_launch_mode) {
    if (g_grid == 0) {
        int dev = 0, cus = 0;
        if (hipGetDevice(&dev) != hipSuccess || hipDeviceGetAttribute(&cus, hipDeviceAttributeMultiprocessorCount, dev) != hipSuccess) { g_grid = -1; return; }
        if (hipFuncSetAttribute((const void*)fwd_kernel, hipFuncAttributeMaxDynamicSharedMemorySize, LDS_BYTES) != hipSuccess) { g_grid = -1; return; }
        int per_cu = 0;
        if (hipOccupancyMaxActiveBlocksPerMultiprocessor(&per_cu, (const void*)fwd_kernel, NTHREADS, LDS_BYTES) != hipSuccess || per_cu < 1) { fprintf(stderr, "occupancy query: %d\n", per_cu); }
        (void)hipGetLastError();
        g_grid = cus;
        if (g_grid != 256) fprintf(stderr, "kernel_launch: grid %d != 256: unsupported\n", g_grid);
    }
    if (g_grid <= 0) return;
#ifndef MK_NO_MEMSET
    (void)hipMemsetAsync((char*)d_ws + WS_CTL, 0, CTL_ZERO_BYTES, stream);
#endif
    Args a{};
    for (int i = 0; i < 12; ++i) a.in[i] = (const float*)d_in[i];
    a.out = (float*)d_out; a.ws = (unsigned char*)d_ws;
    if (n_launch_mode == 1) { a.ph_lo = 0; a.ph_hi = NPHASES; hipLaunchKernelGGL(fwd_kernel, dim3(g_grid), dim3(NTHREADS), LDS_BYTES, stream, a); }
    else for (int k = 0; k < NPHASES; ++k) { a.ph_lo = k; a.ph_hi = k + 1; hipLaunchKernelGGL(fwd_kernel, dim3(g_grid), dim3(NTHREADS), LDS_BYTES, stream, a); }
}
}
#ifndef MK_LAUNCH_MODE
#define MK_LAUNCH_MODE 1
#endif
extern "C" void kernel_launch(void* const* d_in, const int* in_sizes, int n_in, void* d_out, int out_size, void* d_ws, size_t ws_size, hipStream_t stream) {
    mk::launch_all(d_in, d_out, d_ws, stream, MK_LAUNCH_MODE);
}
```

```cpp
#include <hip/hip_runtime.h>
#include <cstdint>
#include <cstdio>
#include <cmath>
#define MK_LAUNCH_MODE 1
#define MK_REORDER
#define MK_M3_DYN
#define AT_FINE
#define M1_DN4
#define M1_SWAP
#define G1B_FAST
#define AT_ZPRE
#define AT_LAM_LATE
#define NP_GREG
#define NP_PIPE 2
#define AT_EPI2
#define M1_NOBAR1
#define HO_G3N
#define HO_M123
#define HO_G23
#define G1A_WT
#define HO_G1
#define HO_M3HIDE
#define NO_HANDOVER_FENCE
#define HO_NOACQ
#define HO_G1EARLY
#define HO_AMG
#define HO_P0
#define HO_NG2
namespace mk {
#define LAS __attribute__((address_space(3)))
#define GAS __attribute__((address_space(1)))
typedef unsigned short bf16_t;
typedef short bf16x8 __attribute__((ext_vector_type(8)));
typedef short s16x4 __attribute__((ext_vector_type(4)));
typedef float f32x2 __attribute__((ext_vector_type(2)));
typedef float f32x4 __attribute__((ext_vector_type(4)));
typedef float f32x16 __attribute__((ext_vector_type(16)));
typedef unsigned u32x2 __attribute__((ext_vector_type(2)));
typedef unsigned u32x4 __attribute__((ext_vector_type(4)));
typedef __bf16 bf16x2_t __attribute__((ext_vector_type(2)));
typedef GAS unsigned gu32;

constexpr int D = 1024, SEQ = 4096, NBATCH = 4, M = NBATCH * SEQ, NINR = 6664, NL = 6656, NLA = 4608;
constexpr int LDP = 4608;
constexpr int P_QA = 0, P_KA = 512, P_VA = 1024, P_ZA = 1536, P_QB = 2048, P_KB = 2560, P_VB = 3072, P_OB = 3584, P_ZB = 4096;
#ifdef MK_REORDER
constexpr int P_YBX = 4096;
#else
constexpr int P_YBX = 512;
#endif
constexpr int P_YA = 0, P_YB = P_YBX, P_SGA = 1024, P_SGB = 2048, P_MG = 3072, P_OUT = 1024;
constexpr float EPS = 1e-6f, LOG2E = 1.4426950408889634f, QSCALE = 0.125f * 1.4426950408889634f, KSCALE = 0.08838834764831845f;
constexpr int NWAVES = 8, NTHREADS = 512;

constexpr size_t MiB = 1u << 20;
#ifdef HO_P0
constexpr size_t WS_CTL = 0, CTL_ZERO_BYTES = 65536;
#else
constexpr size_t WS_CTL = 0, CTL_ZERO_BYTES = 32768;
#endif
constexpr size_t WS_WIN = 1 * MiB;
constexpr size_t WS_WAB = 27 * MiB;
constexpr size_t WS_WOUT = 31 * MiB;
constexpr size_t WS_GATES = 35 * MiB;
constexpr size_t WS_MSC = 35 * MiB + 512 * 1024;
constexpr size_t WS_DN = 36 * MiB;
constexpr size_t WS_HN = 38 * MiB;
constexpr size_t WS_CST = 70 * MiB;
constexpr size_t WS_PROJ = 102 * MiB;
constexpr size_t WS_END = 246 * MiB;
constexpr int CW_BAR = 4096, CW_M3Q = 1024, CW_PANEL2 = 1152, CW_PANEL = 2048;

constexpr int RING_BYTES = 131072, WSF_OFF = 131072, LDSCTL_OFF = 135168, MISC_OFF = LDSCTL_OFF + 320, LDS_BYTES = 147456;

__device__ __forceinline__ unsigned cvtpk(float lo, float hi) { f32x2 v = {lo, hi}; bf16x2_t b = __builtin_convertvector(v, bf16x2_t); return __builtin_bit_cast(unsigned, b); }
__device__ __forceinline__ float bflo(unsigned u) { return __uint_as_float(u << 16); }
__device__ __forceinline__ float bfhi(unsigned u) { return __uint_as_float(u & 0xffff0000u); }
__device__ __forceinline__ float bf1(bf16_t u) { return __uint_as_float((unsigned)u << 16); }
__device__ __forceinline__ float ex2(float x) { return __builtin_amdgcn_exp2f(x); }
__device__ __forceinline__ float rcp(float x) { return __builtin_amdgcn_rcpf(x); }
__device__ __forceinline__ float sigm(float x) { return rcp(1.f + ex2(-x * LOG2E)); }
__device__ __forceinline__ float silu(float x) { return x * sigm(x); }
__device__ __forceinline__ float bperm(float v, int src_lane) { return __uint_as_float((unsigned)__builtin_amdgcn_ds_bpermute(src_lane << 2, (int)__float_as_uint(v))); }
template <int CTRL, int ROWMASK> __device__ __forceinline__ float dppa_f(float v) {
    return __uint_as_float((unsigned)__builtin_amdgcn_update_dpp(0, (int)__float_as_uint(v), CTRL, ROWMASK, 0xF, false)); }
__device__ __forceinline__ float wave_sum_dpp(float v) {
    v += dppa_f<0x111, 0xF>(v); v += dppa_f<0x112, 0xF>(v); v += dppa_f<0x114, 0xF>(v); v += dppa_f<0x118, 0xF>(v);
    v += dppa_f<0x142, 0xA>(v); v += dppa_f<0x143, 0xC>(v);
    return __uint_as_float((unsigned)__builtin_amdgcn_readlane((int)__float_as_uint(v), 63));
}
__device__ __forceinline__ float wave_sum(float v, int lane) {
#pragma unroll
    for (int o = 1; o < 64; o <<= 1) v += bperm(v, lane ^ o);
    return v;
}
__device__ __forceinline__ int crow(int r, int hi) { return (r & 3) + 8 * (r >> 2) + 4 * hi; }
#define LDS_WAIT() asm volatile("s_waitcnt lgkmcnt(0)" ::: "memory")
#define VM_WAIT() asm volatile("s_waitcnt vmcnt(0)" ::: "memory")
#define SBAR() __builtin_amdgcn_sched_barrier(0)
#define WG_BAR() do { asm volatile("s_waitcnt vmcnt(0) lgkmcnt(0)\n\ts_barrier" ::: "memory"); } while (0)

#define XB_TMO      128
#define XB_XCNT(j)  (256  + 64 * (j))
#define XB_XSUB(j)  (1280 + 64 * (j))
#define XB_XGEN(j)  (2304 + 64 * (j))
#define XB_TOP      3328
#define XB_TOPGEN   3392
#define XCD_BAR_WORDS 3456
#define XB_SPIN_CAP (1u << 18)
__device__ __forceinline__ unsigned xb_ld(unsigned* p)              { return __hip_atomic_load(p, __ATOMIC_RELAXED, __HIP_MEMORY_SCOPE_AGENT); }
__device__ __forceinline__ unsigned xb_add(unsigned* p, unsigned v) { return __hip_atomic_fetch_add(p, v, __ATOMIC_RELAXED, __HIP_MEMORY_SCOPE_AGENT); }
__device__ __forceinline__ unsigned xb_xcc_id() { return (unsigned)__builtin_amdgcn_s_getreg((3 << 11) | 20) & 0xFu; }
#define XB_SPIN(cond, bar) do { unsigned _sp = 0; while (cond) { __builtin_amdgcn_s_sleep(1); \
    if ((++_sp & 255u) == 0u) { if (xb_ld(&(bar)[XB_TMO])) break; if (_sp > XB_SPIN_CAP) { atomicAdd(&(bar)[XB_TMO], 1u); break; } } } } while (0)
#define XB_SPIN4(ptr, val, bar) do { unsigned* p_ = (ptr); const unsigned v_ = (val); unsigned s0_ = xb_ld(p_), s1_ = xb_ld(p_), s2_ = xb_ld(p_), s3_ = xb_ld(p_), _sp = 0; \
    for (;;) { if (s0_ != v_) break; s0_ = xb_ld(p_); if (s1_ != v_) break; s1_ = xb_ld(p_); if (s2_ != v_) break; s2_ = xb_ld(p_); if (s3_ != v_) break; s3_ = xb_ld(p_); \
        if ((++_sp & 63u) == 0u) { if (xb_ld(&(bar)[XB_TMO])) break; if (_sp > (XB_SPIN_CAP >> 2)) { atomicAdd(&(bar)[XB_TMO], 1u); break; } } } } while (0)
struct XcdBarrier { unsigned* bar; unsigned x; volatile LAS unsigned* st; int wave; };
__device__ __forceinline__ int lane_now() { unsigned m = ~0u; asm volatile("" : "+s"(m)); return (int)__builtin_amdgcn_mbcnt_hi(m, __builtin_amdgcn_mbcnt_lo(m, 0u)); }
__device__ __forceinline__ bool is_t0(int wave) { return wave == 0 && lane_now() == 0; }
__device__ __forceinline__ XcdBarrier xcd_barrier_post(unsigned* bar, volatile LAS unsigned* st, int wave) {
    XcdBarrier b; b.bar = bar; b.x = xb_xcc_id(); b.st = st; b.wave = wave;
    if (is_t0(wave)) (void)xb_add(&bar[XB_XCNT(b.x)], 1u);
    return b;
}
__device__ __forceinline__ void xcd_barrier_complete(unsigned* bar, unsigned x, unsigned& nloc, unsigned& nx) {
    const unsigned G = gridDim.x * gridDim.y * gridDim.z;
    unsigned sum, cnt, mine, sp = 0u;
    for (;;) {
        sum = 0u; cnt = 0u; mine = 0u;
#pragma unroll
        for (unsigned j = 0; j < 16; ++j) { const unsigned c = xb_ld(&bar[XB_XCNT(j)]); sum += c; cnt += (c > 0u) ? 1u : 0u; mine = (j == x) ? c : mine; }
        if (sum == G) break;
        __builtin_amdgcn_s_sleep(1);
        if ((++sp & 255u) == 0u) { if (xb_ld(&bar[XB_TMO])) break; if (sp > XB_SPIN_CAP) { atomicAdd(&bar[XB_TMO], 1u); break; } }
    }
    nloc = mine > 0u ? mine : 1u; nx = cnt > 0u ? cnt : 1u;
}
__device__ __forceinline__ void xcd_barrier(const XcdBarrier& b) {
    asm volatile("s_waitcnt vmcnt(0)" ::: "memory");
    __syncthreads();
    if (is_t0(b.wave)) {
        unsigned* bar = b.bar; unsigned bx = b.x; asm volatile("" : "+s"(bx));
        __builtin_amdgcn_s_waitcnt(0);
        unsigned nloc = b.st[0], nx = b.st[1];
        if (nloc == 0u) { xcd_barrier_complete(bar, bx, nloc, nx); b.st[0] = nloc; b.st[1] = nx; }
        const unsigned old = xb_add(&bar[XB_XSUB(bx)], 1u);
        const unsigned gen = old / nloc;
        if (old + 1u == (gen + 1u) * nloc) {
            __builtin_amdgcn_fence(__ATOMIC_RELEASE, "agent");
            asm volatile("s_waitcnt vmcnt(0)" ::: "memory");
            const unsigned og = xb_add(&bar[XB_TOP], 1u);
            const unsigned tg = og / nx;
            __builtin_amdgcn_fence(__ATOMIC_ACQUIRE, "agent");
#ifdef MK_BAR_DIRECT
            if (og + 1u == (tg + 1u) * nx) {
#pragma unroll
                for (unsigned j = 0; j < 16; ++j) (void)xb_add(&bar[XB_XGEN(j)], 1u);
            } else XB_SPIN(xb_ld(&bar[XB_XGEN(bx)]) == gen, bar);
#else
            if (og + 1u == (tg + 1u) * nx) xb_add(&bar[XB_TOPGEN], 1u);
#ifdef MK_SPIN4
            else XB_SPIN4(&bar[XB_TOPGEN], tg, bar);
#else
            else XB_SPIN(xb_ld(&bar[XB_TOPGEN]) == tg, bar);
#endif
            xb_add(&bar[XB_XGEN(bx)], 1u);
#endif
            asm volatile("s_waitcnt vmcnt(0)" ::: "memory");
        } else {
            __builtin_amdgcn_fence(__ATOMIC_ACQUIRE, "agent");
#ifdef MK_SPIN4
            XB_SPIN4(&bar[XB_XGEN(bx)], gen, bar);
            asm volatile("s_waitcnt vmcnt(3)" ::: "memory");
#else
            XB_SPIN(xb_ld(&bar[XB_XGEN(bx)]) == gen, bar);
            asm volatile("s_waitcnt vmcnt(0)" ::: "memory");
#endif
        }
    }
    __syncthreads();
}

constexpr int BM = 256, BK = 64, HALF = 128, HTB = HALF * BK * 2, NXCD = 8, WGM = 4;
__host__ __device__ __forceinline__ int lds_byte(int r, int c) { const int st = (r >> 4) * 2 + (c >> 5), rr = r & 15, cc = c & 31, ob = rr * 64 + cc * 2; return st * 1024 + (ob ^ (((ob >> 9) & 1) << 5)); }
__host__ __device__ __forceinline__ void stage_rc(int b, int& R, int& C) { const int st = b / 1024, sb = b % 1024, swz = sb ^ (((sb >> 9) & 1) << 5); R = (st >> 1) * 16 + swz / 64; C = (st & 1) * 32 + (swz % 64) / 2; }
__host__ __device__ __forceinline__ int perm32(int rho) { const int n = rho >> 4, i = rho & 15; return 8 * (i >> 2) + 4 * n + (i & 3); }
struct Unit { int pm, pn; };
struct Gemm { const bf16_t* A; const bf16_t* Bt; int M, N, K, lda; int wide = 0; int ajump = 0; };
struct StaticOrder {
    int nM, nN, nwg, G, c, max_i;
    __device__ void init(int M_, int N_, int G_, int c_) { nM = M_ / BM; nN = N_ / BM; nwg = nM * nN; G = G_; c = c_; max_i = 1 << 30; }
    __device__ bool next(int i, Unit& u) const {
        if (i >= max_i) return false;
        const long L = (long)i * G + c; if (L >= nwg) return false;
        return tile((int)L, u);
    }
    __device__ bool tile(int L, Unit& u) const {
        int wgid = L; { const int q = nwg / NXCD, r = nwg % NXCD, xcd = wgid % NXCD, off = wgid / NXCD; wgid = (xcd < r ? xcd * (q + 1) : r * (q + 1) + (xcd - r) * q) + off; }
        const int nig = WGM * nN, gid = wgid / nig, fm = gid * WGM, gsz = (nM - fm) < WGM ? (nM - fm) : WGM;
        u.pm = fm + ((wgid % nig) % gsz); u.pn = (wgid % nig) / gsz; return true;
    }
};
struct HalfOrder {
    StaticOrder base; int first;
    __device__ void init(int M_, int N_, int G_, int c_, int rounds) { base.init(M_, N_, G_, c_); first = rounds * G_; }
    __device__ bool next(int i, Unit& u) const { if (i >= 1) return false; const int L = first + (base.c >> 1); if (L >= base.nwg) return false; Unit t; base.tile(L, t); u.pm = 2 * t.pm + (base.c & 1); u.pn = t.pn; return true; }
};
struct PairedOrder {
    StaticOrder base;
    __device__ void init(int M_, int N_merge, int G_, int c_) { base.init(M_, N_merge, G_, c_); }
    __device__ bool next(int i, Unit& u) const { if (i >= 2) return false; Unit m; if (!base.next(0, m)) return false; u.pm = m.pm; u.pn = 2 * m.pn + i; return true; }
};
__device__ __forceinline__ void st16_wt(unsigned char* ws, size_t off, u32x4 v) {
    __builtin_amdgcn_raw_buffer_store_b128(v, __builtin_amdgcn_make_buffer_rsrc((void*)ws, 0, 0x7fffffff, 0x00020000), (unsigned)off, 0, 16); }
template <int MODE> struct Epi {
    static constexpr bool MID = (MODE == 2);
    bf16_t* O; int ldc; const bf16_t* GA; const bf16_t* GB;
    int nts = 0;
    int half = 0;
    int wide = 0;
    int wt = 0;
    __device__ __forceinline__ void operator()(const f32x4 (&acc)[2][2][4][2], const Unit& u, int wr, int wc, int fr_, int fq_) const {
        int fr = fr_, fq = fq_; asm volatile("" : "+v"(fr), "+v"(fq));
#ifdef MK_X_NOEPI
        { int never_ = 0; asm volatile("" : "+s"(never_)); if (!never_) return; }
#endif
#ifdef MK_X_EPILOCAL
        const int row0 = (MODE == 0 ? 0 : u.pm * (half ? HALF : BM)) + wr * 64 + fr;
#else
        const int row0 = u.pm * (half ? HALF : BM) + wr * 64 + fr;
#endif
        if (MODE == 1) {
            const int col0 = u.pn * HALF + wc * 32 + 8 * fq;
#pragma unroll
            for (int ai = 0; ai < 2; ++ai)
#pragma unroll
                for (int m = 0; m < 4; ++m) { const size_t ro = (size_t)(row0 + ai * HALF + m * 16) * ldc + col0;
                    float ra[8], sb[8];
#pragma unroll
#ifdef G1B_FAST
                    for (int j = 0; j < 4; ++j) {
                        const float db0 = 1.f + ex2(-acc[ai][1][m][0][j] * LOG2E), db1 = 1.f + ex2(-acc[ai][1][m][1][j] * LOG2E);
                        const float da0 = 1.f + ex2(-acc[ai][0][m][0][j] * LOG2E), da1 = 1.f + ex2(-acc[ai][0][m][1][j] * LOG2E);
                        sb[j] = rcp(db0); sb[4 + j] = rcp(db1); ra[j] = db0 * rcp(da0); ra[4 + j] = db1 * rcp(da1); }
#else
                    for (int j = 0; j < 4; ++j) { const float b0 = sigm(acc[ai][1][m][0][j]), b1 = sigm(acc[ai][1][m][1][j]); sb[j] = b0; sb[4 + j] = b1;
                        ra[j] = sigm(acc[ai][0][m][0][j]) * rcp(b0); ra[4 + j] = sigm(acc[ai][0][m][1][j]) * rcp(b1); }
#endif
                    *(u32x4*)(O + ro) = (u32x4){cvtpk(ra[0], ra[1]), cvtpk(ra[2], ra[3]), cvtpk(ra[4], ra[5]), cvtpk(ra[6], ra[7])};
                    *(u32x4*)((bf16_t*)GB + ro) = (u32x4){cvtpk(sb[0], sb[1]), cvtpk(sb[2], sb[3]), cvtpk(sb[4], sb[5]), cvtpk(sb[6], sb[7])}; }
            return;
        }
        const int col0 = u.pn * BM + (MODE == 0 && wide ? wc * 64 : wc * 32) + 8 * fq; const int bjs = (MODE == 0 && wide) ? 32 : HALF;
#ifdef HOOK1
        u32x4 gq[2][4][2];
        if (MODE == 2) {
#pragma unroll
            for (int ai = 0; ai < 2; ++ai)
#pragma unroll
                for (int m = 0; m < 4; ++m)
#pragma unroll
                    for (int bj = 0; bj < 2; ++bj) gq[ai][m][bj] = *(const u32x4*)(GB + (size_t)(row0 + ai * HALF + m * 16) * ldc + col0 + bj * HALF);
        }
#endif
#pragma unroll
        for (int ai = 0; ai < 2; ++ai) {
            if (ai == 1 && half) break;
            u32x4 g[4][2];
#ifdef MK_X_NOHOOK
            if (false) {
#else
            if (MODE == 2) {
#endif
#pragma unroll
                for (int m = 0; m < 4; ++m)
#pragma unroll
#ifdef HOOK1
                    for (int bj = 0; bj < 2; ++bj) g[m][bj] = gq[ai][m][bj];
#else
                    for (int bj = 0; bj < 2; ++bj) g[m][bj] = *(const u32x4*)(GB + (size_t)(row0 + ai * HALF + m * 16) * ldc + col0 + bj * HALF);
#endif
            }
#pragma unroll
            for (int m = 0; m < 4; ++m) { const size_t ro = (size_t)(row0 + ai * HALF + m * 16) * ldc + col0;
#pragma unroll
                for (int bj = 0; bj < 2; ++bj) { f32x4 v0 = acc[ai][bj][m][0], v1 = acc[ai][bj][m][1];
#ifdef MK_X_NOHOOK
                    if (false) { const u32x4 gg = g[m][bj];
#else
                    if (MODE == 2) { const u32x4 gg = g[m][bj];
#endif
                        v0[0] *= bflo(gg.x); v0[1] *= bfhi(gg.x); v0[2] *= bflo(gg.y); v0[3] *= bfhi(gg.y); v1[0] *= bflo(gg.z); v1[1] *= bfhi(gg.z); v1[2] *= bflo(gg.w); v1[3] *= bfhi(gg.w); }
                    u32x4 w; w.x = cvtpk(v0[0], v0[1]); w.y = cvtpk(v0[2], v0[3]); w.z = cvtpk(v1[0], v1[1]); w.w = cvtpk(v1[2], v1[3]);
                    if (MODE == 0 && nts) __builtin_nontemporal_store(w, (u32x4*)(O + ro + bj * bjs));
                    else if (MODE == 0 && wt) __builtin_amdgcn_raw_buffer_store_b128(w, __builtin_amdgcn_make_buffer_rsrc((void*)O, 0, 0x7fffffff, 0x00020000), (unsigned)((ro + bj * bjs) * 2), 0, 16);
                    else if (MODE == 2 && wt) __builtin_amdgcn_raw_buffer_store_b128(w, __builtin_amdgcn_make_buffer_rsrc((void*)O, 0, 0x7fffffff, 0x00020000), (unsigned)((ro + bj * HALF) * 2), 0, 16);
                    else *(u32x4*)(O + ro + bj * (MODE == 0 ? bjs : HALF)) = w; } }
            if (MODE == 2) asm volatile("" ::: "memory"); }
    }
    __device__ __forceinline__ void mid(f32x4 (&acc)[2][2][4][2], const Unit& u, int wr, int wc, int fr_, int fq_) const {
        int fr = fr_, fq = fq_; asm volatile("" : "+v"(fr), "+v"(fq));
        const int row0 = u.pm * BM + wr * 64 + fr, col0 = u.pn * BM + wc * 32 + 8 * fq;
#ifdef HOOK1
        u32x4 g[2][4][2];
#pragma unroll
        for (int ai = 0; ai < 2; ++ai)
#pragma unroll
            for (int m = 0; m < 4; ++m)
#pragma unroll
                for (int bj = 0; bj < 2; ++bj) g[ai][m][bj] = *(const u32x4*)(GA + (size_t)(row0 + ai * HALF + m * 16) * ldc + col0 + bj * HALF);
#pragma unroll
        for (int ai = 0; ai < 2; ++ai)
#pragma unroll
            for (int m = 0; m < 4; ++m)
#pragma unroll
                for (int bj = 0; bj < 2; ++bj) { const u32x4 a = g[ai][m][bj]; f32x4& v0 = acc[ai][bj][m][0]; f32x4& v1 = acc[ai][bj][m][1];
                    v0[0] *= bflo(a.x); v0[1] *= bfhi(a.x); v0[2] *= bflo(a.y); v0[3] *= bfhi(a.y); v1[0] *= bflo(a.z); v1[1] *= bfhi(a.z); v1[2] *= bflo(a.w); v1[3] *= bfhi(a.w); }
        asm volatile("" ::: "memory");
#else
#pragma unroll
        for (int ai = 0; ai < 2; ++ai) {
            u32x4 g[4][2];
#pragma unroll
            for (int m = 0; m < 4; ++m)
#pragma unroll
                for (int bj = 0; bj < 2; ++bj) g[m][bj] = *(const u32x4*)(GA + (size_t)(row0 + ai * HALF + m * 16) * ldc + col0 + bj * HALF);
#pragma unroll
            for (int m = 0; m < 4; ++m)
#pragma unroll
                for (int bj = 0; bj < 2; ++bj) { const u32x4 a = g[m][bj]; f32x4& v0 = acc[ai][bj][m][0]; f32x4& v1 = acc[ai][bj][m][1];
                    v0[0] *= bflo(a.x); v0[1] *= bfhi(a.x); v0[2] *= bflo(a.y); v0[3] *= bfhi(a.y); v1[0] *= bflo(a.z); v1[1] *= bfhi(a.z); v1[2] *= bflo(a.w); v1[3] *= bfhi(a.w); }
            asm volatile("" ::: "memory"); }
#endif
    }
};

struct NoHook { static constexpr bool ON = false, MID = false; __device__ __forceinline__ void operator()(int) const {} };
template <class EpiT, bool ALIGN_EPI, class OrderT, bool HALFM = false, class HookT = NoHook>
__device__ __forceinline__ void gemm_phase(LAS unsigned char* lds, const Gemm g, const OrderT& S, const EpiT& E, int wave_, const HookT& hook = HookT()) {
    int tid_ = lane_now() + 64 * wave_; asm volatile("" : "+v"(tid_));
    const int tid = tid_, wid = wave_, lane = tid & 63, wr = wid >> 2, wc = wid & 3, fr = lane & 15, fq = lane >> 4;
    const int K = g.K, nt = K / BK, lda = g.lda;
    unsigned voffA[2], voffB[2];
#pragma unroll
    for (int i = 0; i < 2; ++i) { int R, C; stage_rc(tid * 16 + i * 8192, R, C); const int Rb = (g.wide ? 2 * (R & ~31) : (R & ~31)) + perm32(R & 31);
        voffA[i] = (unsigned)(R * lda + C) * 2u; voffB[i] = (unsigned)(Rb * K + C) * 2u; }
    const size_t kstep = (size_t)(BK * 2);
    const size_t hsA = HALFM ? 0 : (size_t)HALF * lda * 2, hsB = (size_t)(g.wide ? 32 : HALF) * K * 2, tsA = HALFM ? (size_t)HALF * lda * 2 : 2 * hsA, tsB = (size_t)BM * K * 2;
    const unsigned ldsw = (unsigned)wid * 1024u;
    const int aoff = lds_byte(wr * 64 + fr, fq * 8), boff = lds_byte(wc * 32 + fr, fq * 8);
#define PG8_SA(b, h) (((b) * 2 + (h)) * HTB)
#define PG8_SB(b, h) ((4 + (b) * 2 + (h)) * HTB)
#define PG8_STAGE(bufoff, gbase, voff) do { _Pragma("unroll") for (int _i = 0; _i < 2; ++_i) \
        __builtin_amdgcn_global_load_lds((const unsigned*)((const char*)(gbase) + (voff)[_i]), (LAS unsigned*)(lds + (bufoff) + ldsw + _i * 8192), 16, 0, 0); } while (0)
#define PG8_LDA(dst, b, h) do { _Pragma("unroll") for (int m = 0; m < 4; ++m) _Pragma("unroll") for (int k = 0; k < 2; ++k) dst[m][k] = *(const LAS bf16x8*)(lds + PG8_SA(b, h) + aoff + m * 2048 + k * 1024); } while (0)
#define PG8_LDB(dst, b, h) do { _Pragma("unroll") for (int n = 0; n < 2; ++n) _Pragma("unroll") for (int k = 0; k < 2; ++k) dst[n][k] = *(const LAS bf16x8*)(lds + PG8_SB(b, h) + boff + n * 2048 + k * 1024); } while (0)
#define PG8_MMA(ai, bj, At, Bt) do { __builtin_amdgcn_s_setprio(1); _Pragma("unroll") for (int m = 0; m < 4; ++m) _Pragma("unroll") for (int n = 0; n < 2; ++n) _Pragma("unroll") for (int k = 0; k < 2; ++k) \
        acc[ai][bj][m][n] = __builtin_amdgcn_mfma_f32_16x16x32_bf16(Bt[n][k], At[m][k], acc[ai][bj][m][n], 0, 0, 0); __builtin_amdgcn_s_setprio(0); } while (0)
#define PG8_WAIT_V(n) asm volatile("s_waitcnt vmcnt(" #n ")" ::: "memory")
#define PG8_WAIT_L(n) asm volatile("s_waitcnt lgkmcnt(" #n ")" ::: "memory")
#define PG8_BAR __builtin_amdgcn_s_barrier()
#define PG8_SCHED __builtin_amdgcn_sched_barrier(0)
    Unit cur, nxt; int ui = 0;
    if (!S.next(0, cur)) return;
    f32x4 acc[2][2][4][2];
#pragma unroll
    for (int a = 0; a < 2; ++a)
#pragma unroll
        for (int b = 0; b < 2; ++b)
#pragma unroll
            for (int m = 0; m < 4; ++m)
#pragma unroll
                for (int n = 0; n < 2; ++n) acc[a][b][m][n] = (f32x4){0.f, 0.f, 0.f, 0.f};
    bf16x8 At[4][2], B0[2][2], B1[2][2];
    const char* cA = (const char*)g.A + (size_t)cur.pm * tsA; const char* cB = (const char*)g.Bt + (size_t)cur.pn * tsB;
    PG8_STAGE(PG8_SB(0, 0), cB, voffB); PG8_STAGE(PG8_SB(0, 1), cB + hsB, voffB); PG8_STAGE(PG8_SA(0, 0), cA, voffA); PG8_STAGE(PG8_SA(0, 1), cA + hsA, voffA);
    if (wr == 1) PG8_BAR;
    PG8_WAIT_V(2); PG8_BAR;
    PG8_STAGE(PG8_SB(1, 0), cB + kstep, voffB); PG8_STAGE(PG8_SA(1, 0), cA + kstep, voffA); PG8_STAGE(PG8_SB(1, 1), cB + hsB + kstep, voffB);
    PG8_WAIT_V(6); PG8_BAR;
    for (;;) {
        const bool has_next = S.next(ui + 1, nxt);
        const char* nA = has_next ? (const char*)g.A + (size_t)nxt.pm * tsA : cA; const char* nB = has_next ? (const char*)g.Bt + (size_t)nxt.pn * tsB : cB;
        for (int t = 0; t < nt; t += 2) {
            const bool last = (t == nt - 2);
            const size_t j1 = (t + 1 >= nt / 2) ? (size_t)g.ajump : 0, j2 = (t + 2 >= nt / 2) ? (size_t)g.ajump : 0;
            const char* a1 = cA + (size_t)(t + 1) * kstep + j1;
            const char* a2 = last ? nA : cA + (size_t)(t + 2) * kstep + j2; const char* b2 = last ? nB : cB + (size_t)(t + 2) * kstep;
            const char* a3 = a2 + kstep; const char* b3 = b2 + kstep;
#ifndef MK_X_NOHOOK
            if constexpr (HookT::ON && HookT::MID) { if (ui == 0 && t == nt / 2) hook(wid); }
            if constexpr (EpiT::MID) { if (t == nt / 2) E.mid(acc, cur, wr, wc, fr, fq); }
#endif
            PG8_LDB(B0, 0, 0); PG8_LDB(B1, 0, 1); PG8_SCHED; PG8_LDA(At, 0, 0); PG8_STAGE(PG8_SA(1, 1), a1 + hsA, voffA);
            PG8_WAIT_V(8); PG8_WAIT_L(0); PG8_BAR; PG8_MMA(0, 0, At, B0); PG8_MMA(0, 1, At, B1); PG8_BAR; PG8_SCHED;
            if constexpr (!HALFM) PG8_LDA(At, 0, 1); PG8_STAGE(PG8_SB(0, 0), b2, voffB); PG8_STAGE(PG8_SB(0, 1), b2 + hsB, voffB); PG8_STAGE(PG8_SA(0, 0), a2, voffA);
            PG8_WAIT_V(8); PG8_WAIT_L(0); PG8_BAR; if constexpr (!HALFM) { PG8_MMA(1, 0, At, B0); PG8_MMA(1, 1, At, B1); } PG8_BAR; PG8_SCHED;
            PG8_LDB(B0, 1, 0); PG8_LDB(B1, 1, 1); PG8_SCHED; PG8_LDA(At, 1, 0); PG8_STAGE(PG8_SA(0, 1), a2 + hsA, voffA);
            PG8_WAIT_V(8); PG8_WAIT_L(0); PG8_BAR; PG8_MMA(0, 0, At, B0); PG8_MMA(0, 1, At, B1); PG8_BAR; PG8_SCHED;
            if constexpr (!HALFM) PG8_LDA(At, 1, 1); PG8_STAGE(PG8_SB(1, 0), b3, voffB); PG8_STAGE(PG8_SB(1, 1), b3 + hsB, voffB); PG8_STAGE(PG8_SA(1, 0), a3, voffA);
            PG8_WAIT_V(8); PG8_WAIT_L(0); PG8_BAR; if constexpr (!HALFM) { PG8_MMA(1, 0, At, B0); PG8_MMA(1, 1, At, B1); } PG8_BAR; PG8_SCHED;
        }
        if constexpr (ALIGN_EPI) { if (wr == 0) PG8_BAR; }
        if constexpr (HookT::ON && !HookT::MID) { static_assert(ALIGN_EPI, "hook needs aligned wave halves"); if (ui == 0) { hook(wid); PG8_BAR; } }
        E(acc, cur, wr, wc, fr, fq);
        if (!has_next) break;
#pragma unroll
        for (int a = 0; a < 2; ++a)
#pragma unroll
            for (int b = 0; b < 2; ++b)
#pragma unroll
                for (int m = 0; m < 4; ++m)
#pragma unroll
                    for (int n = 0; n < 2; ++n) acc[a][b][m][n] = (f32x4){0.f, 0.f, 0.f, 0.f};
        cur = nxt; cA = nA; cB = nB; ++ui;
        if constexpr (ALIGN_EPI) { if (wr == 1) PG8_BAR; }
    }
    PG8_WAIT_V(0);
    if constexpr (!ALIGN_EPI) { if (wr == 0) PG8_BAR; }
    PG8_BAR;
#undef PG8_SA
#undef PG8_SB
#undef PG8_STAGE
#undef PG8_LDA
#undef PG8_LDB
#undef PG8_MMA
#undef PG8_WAIT_V
#undef PG8_WAIT_L
#undef PG8_BAR
#undef PG8_SCHED
}

struct Frame {
    LAS unsigned char* lds;
    int tid, lane, wave, vcu, G;
    unsigned char* ws;
};
template <int OFF> __device__ __forceinline__ const float* ldarg() { const GAS float* p; asm volatile("s_load_dwordx2 %0, %1, %2\n\ts_waitcnt lgkmcnt(0)" : "=s"(p) : "s"(__builtin_amdgcn_kernarg_segment_ptr()), "n"(OFF)); return (const float*)p; }
#define ARGP(i) (ldarg<(i) * 8>())
#define ARGO() ((float*)ldarg<96>())

#ifdef MK_TPROBE
__device__ __forceinline__ void tstamp_k(Frame& F, int kind) {
    if (is_t0(F.wave)) { volatile LAS unsigned* MISC = (volatile LAS unsigned*)(F.lds + MISC_OFF); const unsigned long long tn = __builtin_amdgcn_s_memrealtime(); const unsigned long long tp = ((unsigned long long)MISC[17] << 32) | MISC[16];
        if (kind == MK_TPROBE || MK_TPROBE == 99) MISC[18] = __float_as_uint(__uint_as_float(MISC[18]) + (float)(tn - tp) * 0.01f); MISC[16] = (unsigned)tn; MISC[17] = (unsigned)(tn >> 32); } }
#ifdef MK_TSK_AS
#define TSK(k) tstamp_k(F, MK_TSK_AS)
#else
#define TSK(k) tstamp_k(F, k)
#endif
#else
#define TSK(k) do {} while (0)
#endif
__device__ __forceinline__ void p0_item(const float* W, int ldw, int k0, int sc0, bf16_t* WT, int ldk, int dr0, int dk0, float scale, LAS float* scr, int lane, bool wt = false) {
#ifdef P0_UNROLL
#pragma unroll P0_UNROLL
#else
#pragma unroll 8
#endif
    for (int i = 0; i < 32; ++i) { const int kk = 2 * i + (lane >> 5); scr[kk * 33 + (lane & 31)] = __builtin_nontemporal_load(&W[(size_t)(k0 + kk) * ldw + sc0 + (lane & 31)]) * scale; }
    LDS_WAIT(); asm volatile("" ::: "memory");
    const int c = lane & 7;
#pragma unroll
    for (int j = 0; j < 4; ++j) { const int n = (lane >> 3) + 8 * j; const LAS float* s = scr + (8 * c) * 33 + n;
        u32x4 o; o.x = cvtpk(s[0 * 33], s[1 * 33]); o.y = cvtpk(s[2 * 33], s[3 * 33]); o.z = cvtpk(s[4 * 33], s[5 * 33]); o.w = cvtpk(s[6 * 33], s[7 * 33]);
        if (wt) __builtin_amdgcn_raw_buffer_store_b128(o, __builtin_amdgcn_make_buffer_rsrc((void*)WT, 0, 0x7fffffff, 0x00020000), (unsigned)(((size_t)(dr0 + n) * ldk + dk0 + k0 + 8 * c) * 2), 0, 16);
        else *(GAS u32x4*)(WT + (size_t)(dr0 + n) * ldk + dk0 + k0 + 8 * c) = o; }
    LDS_WAIT(); asm volatile("" ::: "memory");
}
#ifdef P0_PIPE
struct P0D { const float* src; bf16_t* dst; int ldw, ldk; float scale; };
__device__ __forceinline__ P0D p0_desc(Frame& F, int it) {
    constexpr int I_IN = 16 * (NL / 32), I_AB = 8 * 32, I_OUT = 16 * 32;
    bf16_t* WIN = (bf16_t*)(F.ws + WS_WIN); bf16_t* WAB = (bf16_t*)(F.ws + WS_WAB); bf16_t* WOUT = (bf16_t*)(F.ws + WS_WOUT);
    P0D d; int r = it;
    if (r < 2 * I_IN) { const int l = r / I_IN; r -= l * I_IN; const int kb = r / (NL / 32), nb = r % (NL / 32); const int n0 = nb * 32;
        int dr = n0;
        if (n0 >= NLA) { const int g = n0 - NLA, isb = g >= 1024 ? 1 : 0, gc = g - 1024 * isb; dr = NLA + 256 * (gc >> 7) + 128 * isb + (gc & 127); }
        d.src = ARGP(3) + (size_t)l * D * NINR + (size_t)(kb * 64) * NINR + n0 + (n0 >= NLA ? 8 : 0); d.ldw = NINR;
        d.dst = WIN + (size_t)l * NL * D + (size_t)dr * D + kb * 64; d.ldk = D; d.scale = n0 < 512 ? QSCALE : 1.f; return d; }
    r -= 2 * I_IN;
    if (r < 4 * I_AB) { const int mtx = r / I_AB; r -= mtx * I_AB; const int l = mtx >> 1, which = mtx & 1; const int kb = r / 32, nb = r % 32;
        d.src = (which ? ARGP(10) : ARGP(9)) + (size_t)l * 512 * D + (size_t)(kb * 64) * D + nb * 32; d.ldw = D;
        d.dst = WAB + (size_t)l * D * D + (size_t)(nb * 32) * D + which * 512 + kb * 64; d.ldk = D; d.scale = 1.f; return d; }
    r -= 4 * I_AB;
    { const int l = r / I_OUT; r -= l * I_OUT; const int kb = r / 32, nb = r % 32;
      d.src = ARGP(11) + (size_t)l * D * D + (size_t)(kb * 64) * D + nb * 32; d.ldw = D;
      d.dst = WOUT + (size_t)l * D * D + (size_t)(nb * 32) * D + kb * 64; d.ldk = D; d.scale = 1.f; return d; }
}
__device__ __forceinline__ void p0_weights(Frame& F) {
    LAS float* scr = (LAS float*)(F.lds + 40960 + F.wave * 10240);
    const int gw = F.vcu * NWAVES + F.wave, NGW = F.G * NWAVES, lane = F.lane;
    constexpr int NITEMS = 2 * 16 * (NL / 32) + 4 * 8 * 32 + 2 * 16 * 32;
    float xa[32], xb[32];
    P0D da = p0_desc(F, gw < NITEMS ? gw : 0), db = da;
#define P0_LOAD(d, x) do { _Pragma("unroll") for (int i = 0; i < 32; ++i) x[i] = __builtin_nontemporal_load(&(d).src[(size_t)(2 * i + (lane >> 5)) * (d).ldw + (lane & 31)]); } while (0)
    if (gw < NITEMS) P0_LOAD(da, xa);
#pragma unroll 1
    for (int it = gw; it < NITEMS; it += NGW) {
        const bool more = it + NGW < NITEMS;
        if (more) { db = p0_desc(F, it + NGW); P0_LOAD(db, xb); }
#pragma unroll
        for (int i = 0; i < 32; ++i) scr[(2 * i + (lane >> 5)) * 33 + (lane & 31)] = xa[i] * da.scale;
        LDS_WAIT(); asm volatile("" ::: "memory");
        const int c = lane & 7;
#pragma unroll
        for (int j = 0; j < 4; ++j) { const int n = (lane >> 3) + 8 * j; const LAS float* s = scr + (8 * c) * 33 + n;
            u32x4 o; o.x = cvtpk(s[0 * 33], s[1 * 33]); o.y = cvtpk(s[2 * 33], s[3 * 33]); o.z = cvtpk(s[4 * 33], s[5 * 33]); o.w = cvtpk(s[6 * 33], s[7 * 33]);
            *(GAS u32x4*)(da.dst + (size_t)n * da.ldk + 8 * c) = o; }
        LDS_WAIT(); asm volatile("" ::: "memory");
        if (more) {
#pragma unroll
            for (int i = 0; i < 32; ++i) xa[i] = xb[i];
            da = db; }
    }
#undef P0_LOAD
}
#else
__device__ __forceinline__ void p0_weights(Frame& F, int lsel = -1, bool wt = false) {
    LAS float* scr = (LAS float*)(F.lds + 40960 + F.wave * 10240);
    const int gw = F.vcu * NWAVES + F.wave, NGW = F.G * NWAVES;
    constexpr int I_IN = 16 * (NL / 32);
    constexpr int I_AB = 8 * 32;
    constexpr int I_OUT = 16 * 32;
    constexpr int NITEMS = 2 * I_IN + 4 * I_AB + 2 * I_OUT;
    bf16_t* WIN = (bf16_t*)(F.ws + WS_WIN); bf16_t* WAB = (bf16_t*)(F.ws + WS_WAB); bf16_t* WOUT = (bf16_t*)(F.ws + WS_WOUT);
    for (int it = gw; it < NITEMS; it += NGW) {
        int r = it;
        if (r < 2 * I_IN) { const int l = r / I_IN; r -= l * I_IN; if (lsel >= 0 && l != lsel) continue; const int kb = r / (NL / 32), nb = r % (NL / 32); const int n0 = nb * 32;
            int dr = n0;
            if (n0 >= NLA) { const int g = n0 - NLA, isb = g >= 1024 ? 1 : 0, gc = g - 1024 * isb; dr = NLA + 256 * (gc >> 7) + 128 * isb + (gc & 127); }
            p0_item(ARGP(3) + (size_t)l * D * NINR, NINR, kb * 64, n0 + (n0 >= NLA ? 8 : 0), WIN + (size_t)l * NL * D, D, dr, 0, n0 < 512 ? QSCALE : 1.f, scr, F.lane, wt); continue; }
        r -= 2 * I_IN;
        if (r < 4 * I_AB) { const int mtx = r / I_AB; r -= mtx * I_AB; const int l = mtx >> 1, which = mtx & 1; const int kb = r / 32, nb = r % 32; if (lsel >= 0 && l != lsel) continue;
            p0_item((which ? ARGP(10) : ARGP(9)) + (size_t)l * 512 * D, D, kb * 64, nb * 32, WAB + (size_t)l * D * D, D, nb * 32, which * 512, 1.f, scr, F.lane, wt); continue; }
        r -= 4 * I_AB;
        { const int l = r / I_OUT; r -= l * I_OUT; const int kb = r / 32, nb = r % 32; if (lsel >= 0 && l != lsel) continue;
          p0_item(ARGP(11) + (size_t)l * D * D, D, kb * 64, nb * 32, WOUT + (size_t)l * D * D, D, nb * 32, 0, 1.f, scr, F.lane, wt); }
    }
}

#endif

#ifdef HO_NG2
constexpr bool NWT1 = true;
#else
constexpr bool NWT1 = false;
#endif
#ifdef NP_DPP
#define NP_WSUM(x) wave_sum_dpp(x)
#else
#define NP_WSUM(x) wave_sum(x, lane)
#endif
__device__ __forceinline__ void ho_wait4(Frame& F, int word0) {
    if (F.wave == 0) { const int ln = lane_now(); unsigned* pf = (unsigned*)(F.ws + WS_CTL) + word0 + (ln & 3); unsigned sp_ = 0;
        while (!__all(xb_ld(pf) != 0u)) { __builtin_amdgcn_s_sleep(1); if (++sp_ > XB_SPIN_CAP) break; }
        if (ln == 0) { __builtin_amdgcn_fence(__ATOMIC_ACQUIRE, "agent"); asm volatile("s_waitcnt vmcnt(0)" ::: "memory"); } }
    __syncthreads();
}
template <int MODE>
__device__ __forceinline__ void norm_pass(Frame& F, const float* xin, float* xo, const float* g_post, const float* g_pre, const float* w_in_l, int rbase = -1, int wait_word = -1) {
    LAS float* gwT = (LAS float*)(F.lds);
#ifndef NP_EARLY
    if (MODE != 2) {
        for (int k = F.tid; k < D; k += NTHREADS) {
            const f32x4 a = *(const f32x4*)(w_in_l + (size_t)k * NINR + 4608), b = *(const f32x4*)(w_in_l + (size_t)k * NINR + 4612);
            gwT[0 * D + k] = a[0]; gwT[1 * D + k] = a[1]; gwT[2 * D + k] = a[2]; gwT[3 * D + k] = a[3];
            gwT[4 * D + k] = b[0]; gwT[5 * D + k] = b[1]; gwT[6 * D + k] = b[2]; gwT[7 * D + k] = b[3];
        }
        if (wait_word < 0) __syncthreads();
    }
#endif
    if (wait_word >= 0) ho_wait4(F, wait_word);
    const bf16_t* OUT = (const bf16_t*)(F.ws + WS_PROJ) + P_OUT;
    bf16_t* HN = (bf16_t*)(F.ws + WS_HN); float* GATES = (float*)(F.ws + WS_GATES);
    int lane_ = F.lane; asm volatile("" : "+v"(lane_));
    const int gw = rbase >= 0 ? rbase + F.wave : F.vcu * NWAVES + F.wave, NGW = rbase >= 0 ? NWAVES : F.G * NWAVES, lane = lane_; const int MEND = rbase >= 0 ? rbase + 64 : M;
#ifdef NP_PIPE
    f32x4 vn[4]; u32x2 wn[4];
#define NP_LOAD(mm) do { _Pragma("unroll") for (int j = 0; j < 4; ++j) { vn[j] = __builtin_nontemporal_load((const f32x4*)(xin + (size_t)(mm) * D) + lane + 64 * j); \
        if (MODE >= 1) wn[j] = __builtin_nontemporal_load((const u32x2*)(OUT + (size_t)(mm) * LDP) + lane + 64 * j); } } while (0)
    if (gw < MEND) NP_LOAD(gw);
#ifdef NP_GREG
    f32x4 gpo[4], gpr[4];
#pragma unroll
    for (int j = 0; j < 4; ++j) { if (MODE >= 1) gpo[j] = *((const f32x4*)g_post + lane + 64 * j); if (MODE != 2) gpr[j] = *((const f32x4*)g_pre + lane + 64 * j); }
#endif
#ifdef NP_EARLY
    if (MODE != 2) {
        for (int k = F.tid; k < D; k += NTHREADS) {
            const f32x4 a = *(const f32x4*)(w_in_l + (size_t)k * NINR + 4608), b = *(const f32x4*)(w_in_l + (size_t)k * NINR + 4612);
            gwT[0 * D + k] = a[0]; gwT[1 * D + k] = a[1]; gwT[2 * D + k] = a[2]; gwT[3 * D + k] = a[3];
            gwT[4 * D + k] = b[0]; gwT[5 * D + k] = b[1]; gwT[6 * D + k] = b[2]; gwT[7 * D + k] = b[3];
        }
        __syncthreads();
    }
#endif
#if NP_PIPE == 3
    f32x4 vm[4]; u32x2 wm[4];
#pragma unroll
    for (int j = 0; j < 4; ++j) { vm[j] = vn[j]; if (MODE >= 1) wm[j] = wn[j]; }
    if (gw + NGW < MEND) NP_LOAD(gw + NGW);
#endif
#endif
    for (int m = gw; m < MEND; m += NGW) {
        f32x4 v[4];
#ifdef NP_NOHOIST
        int zrow = 0; asm volatile("" : "+v"(zrow));
#endif
#ifdef NP_PIPE
        u32x2 wc[4];
#pragma unroll
#if NP_PIPE == 3
        for (int j = 0; j < 4; ++j) { v[j] = vm[j]; vm[j] = vn[j]; if (MODE >= 1) { wc[j] = wm[j]; wm[j] = wn[j]; } }
        if (m + 2 * NGW < MEND) NP_LOAD(m + 2 * NGW);
#else
        for (int j = 0; j < 4; ++j) { v[j] = vn[j]; if (MODE >= 1) wc[j] = wn[j]; }
        if (m + NGW < MEND) NP_LOAD(m + NGW);
#endif
#else
#pragma unroll
        for (int j = 0; j < 4; ++j) v[j] = __builtin_nontemporal_load((const f32x4*)(xin + (size_t)m * D) + lane + 64 * j);
#endif
        if (MODE >= 1) {
            f32x4 o[4]; float so = 0.f;
#pragma unroll
#ifdef NP_PIPE
            for (int j = 0; j < 4; ++j) { const u32x2 w = wc[j]; o[j] = (f32x4){bflo(w.x), bfhi(w.x), bflo(w.y), bfhi(w.y)};
#else
            for (int j = 0; j < 4; ++j) { const u32x2 w = __builtin_nontemporal_load((const u32x2*)(OUT + (size_t)m * LDP) + lane + 64 * j); o[j] = (f32x4){bflo(w.x), bfhi(w.x), bflo(w.y), bfhi(w.y)};
#endif
                so += (o[j][0] * o[j][0] + o[j][1] * o[j][1]) + (o[j][2] * o[j][2] + o[j][3] * o[j][3]); }
            const float r1 = rsqrtf(NP_WSUM(so) * (1.f / D) + EPS);
#pragma unroll
#if defined(NP_GREG) && defined(NP_PIPE)
            for (int j = 0; j < 4; ++j) { const f32x4 gp = gpo[j]; v[j] = v[j] + o[j] * r1 * gp;
#else
            for (int j = 0; j < 4; ++j) { const f32x4 gp = *((const f32x4*)g_post + lane + 64 * j); v[j] = v[j] + o[j] * r1 * gp;
#endif
                __builtin_nontemporal_store(v[j], (f32x4*)(xo + (size_t)m * D) + lane + 64 * j); }
        }
        if (MODE != 2) {
            float s = 0.f;
#pragma unroll
            for (int j = 0; j < 4; ++j) s += (v[j][0] * v[j][0] + v[j][1] * v[j][1]) + (v[j][2] * v[j][2] + v[j][3] * v[j][3]);
            const float r = rsqrtf(NP_WSUM(s) * (1.f / D) + EPS);
            float ga[8] = {0.f, 0.f, 0.f, 0.f, 0.f, 0.f, 0.f, 0.f};
#pragma unroll
#if defined(NP_GREG) && defined(NP_PIPE)
            for (int j = 0; j < 4; ++j) { const f32x4 gp = gpr[j]; const f32x4 hv = v[j] * r * gp;
#else
            for (int j = 0; j < 4; ++j) { const f32x4 gp = *((const f32x4*)g_pre + lane + 64 * j); const f32x4 hv = v[j] * r * gp;
#endif
                u32x2 w; w.x = cvtpk(hv[0], hv[1]); w.y = cvtpk(hv[2], hv[3]);
#ifdef HO_P0
                if (MODE == 0 || (MODE == 1 && NWT1)) __hip_atomic_store((unsigned long long*)((u32x2*)(HN + (size_t)m * D) + lane + 64 * j), ((unsigned long long)w.y << 32) | w.x, __ATOMIC_RELAXED, __HIP_MEMORY_SCOPE_AGENT);
                else
#endif
                *((u32x2*)(HN + (size_t)m * D) + lane + 64 * j) = w;

#pragma unroll
#ifdef NP_NOHOIST
                for (int g = 0; g < 8; ++g) { const f32x4 wg = *((const LAS f32x4*)(gwT + g * D + zrow) + lane + 64 * j);
#else
                for (int g = 0; g < 8; ++g) { const f32x4 wg = *((const LAS f32x4*)(gwT + g * D) + lane + 64 * j);
#endif
                    ga[g] += (hv[0] * wg[0] + hv[1] * wg[1]) + (hv[2] * wg[2] + hv[3] * wg[3]); } }
#pragma unroll
            for (int g = 0; g < 8; ++g) ga[g] = NP_WSUM(ga[g]);
            if (lane == 0) {
#ifdef HO_P0
                if (MODE == 0 || (MODE == 1 && NWT1)) {
#pragma unroll
                    for (int g = 0; g < 8; ++g) __hip_atomic_store((unsigned*)(GATES + (size_t)m * 8 + g), __float_as_uint(ga[g]), __ATOMIC_RELAXED, __HIP_MEMORY_SCOPE_AGENT);
                } else
#endif
                { *(f32x4*)(GATES + (size_t)m * 8) = (f32x4){ga[0], ga[1], ga[2], ga[3]}; *(f32x4*)(GATES + (size_t)m * 8 + 4) = (f32x4){ga[4], ga[5], ga[6], ga[7]}; } }
        }
    }
}
constexpr int AT_SLOT = 32768, AT_VOFF = 16384;
__device__ __forceinline__ void glds16(const void* gsrc, unsigned lds_dst) { unsigned keep;
    asm volatile("s_mov_b32 %0, m0\n\ts_mov_b32 m0, %2\n\ts_nop 0\n\tglobal_load_lds_dwordx4 %1, off\n\ts_mov_b32 m0, %0" : "=&s"(keep) : "v"(gsrc), "s"(lds_dst) : "memory"); }
__device__ __forceinline__ void glds16s(const void* sbase_, unsigned voff, unsigned lds_dst) { unsigned keep;
    const unsigned long long b_ = (unsigned long long)sbase_; const void* sbase = (const void*)(((unsigned long long)(unsigned)__builtin_amdgcn_readfirstlane((int)(b_ >> 32)) << 32) | (unsigned)__builtin_amdgcn_readfirstlane((int)b_));
    asm volatile("s_nop 4\n\ts_mov_b32 %0, m0\n\ts_mov_b32 m0, %3\n\ts_nop 0\n\tglobal_load_lds_dwordx4 %1, %2\n\ts_mov_b32 m0, %0" : "=&s"(keep) : "v"(voff), "s"(sbase), "s"(lds_dst) : "memory"); }
#define AT_WAIT_BAR_L() asm volatile("s_waitcnt lgkmcnt(0)\n\ts_barrier" ::: "memory")
#define AT_WAIT_BAR(N) asm volatile("s_waitcnt vmcnt(" #N ") lgkmcnt(0)\n\ts_barrier" ::: "memory")
typedef short v4i16_t __attribute__((ext_vector_type(4)));
__device__ __forceinline__ s16x4 trrd(LAS const unsigned char* p) { return __builtin_bit_cast(s16x4, __builtin_amdgcn_ds_read_tr16_b64_v4i16((LAS v4i16_t*)p)); }
__device__ __forceinline__ bf16x8 tr2(LAS const unsigned char* p) { const s16x4 a = trrd(p), b = trrd(p + 512); return (bf16x8){a[0], a[1], a[2], a[3], b[0], b[1], b[2], b[3]}; }
__device__ __forceinline__ float half_swap_max(float m) { auto rr = __builtin_amdgcn_permlane32_swap(__float_as_uint(m), __float_as_uint(m), false, false); return fmaxf(__uint_as_float(rr[0]), __uint_as_float(rr[1])); }
__device__ __forceinline__ float half_swap_add(float m) { auto rr = __builtin_amdgcn_permlane32_swap(__float_as_uint(m), __float_as_uint(m), false, false); return __uint_as_float(rr[0]) + __uint_as_float(rr[1]); }

__device__ __forceinline__ float max3f(float a, float b, float c) { float r; asm("v_max3_f32 %0, %1, %2, %3" : "=v"(r) : "v"(a), "v"(b), "v"(c)); return r; }
__device__ __forceinline__ float max2f(float a, float b) { float r; asm("v_max_f32_e32 %0, %1, %2" : "=v"(r) : "v"(a), "v"(b)); return r; }
template <int THR, bool PRE = false>
__device__ __forceinline__ void attn_unit(Frame& F, int l, int b, int h, int qb) {
    int lane_ = F.lane; asm volatile("" : "+v"(lane_));
#ifdef AT_PARITY
    const int lane = lane_, r32 = lane & 31, hi = lane >> 5, wid = F.wave, c = wid & 1, wq = wid >> 1;
#else
    const int lane = lane_, r32 = lane & 31, hi = lane >> 5, wid = F.wave, c = wid >> 2, wq = wid & 3;
#endif
    bf16_t* PROJ = (bf16_t*)(F.ws + WS_PROJ);
    const size_t rowbase = (size_t)b * SEQ;
    const int q0 = qb * 128, NT = 2 * (qb + 1);
    const unsigned lds0 = (unsigned)(uintptr_t)F.lds;
    const int kr0 = 8 * wid + (lane >> 4), kr1 = kr0 + 4;
    const unsigned kof0 = (unsigned)(kr0 * LDP + P_KA + h * 128 + ((lane & 15) ^ (kr0 & 15)) * 8) * 2u;
    const unsigned kof1 = (unsigned)(kr1 * LDP + P_KA + h * 128 + ((lane & 15) ^ (kr1 & 15)) * 8) * 2u;
    const unsigned vof0 = (unsigned)(((lane >> 2) + 16 * (wid & 3)) * LDP + P_VA + h * 128 + (lane & 3) * 8 + (wid >> 2) * 32) * 2u;
    const bf16_t* KVb = PROJ + rowbase * LDP;
#define AT_DMA(t, slot) do { const bf16_t* tb_ = KVb + (size_t)(t) * 64 * LDP; const unsigned sb_ = lds0 + (unsigned)(slot) * AT_SLOT; \
        glds16s(tb_, kof0, (unsigned)__builtin_amdgcn_readfirstlane(sb_ + wid * 2048)); \
        glds16s(tb_, kof1, (unsigned)__builtin_amdgcn_readfirstlane(sb_ + wid * 2048 + 1024)); \
        glds16s(tb_, vof0, (unsigned)__builtin_amdgcn_readfirstlane(sb_ + AT_VOFF + wid * 1024)); \
        glds16s(tb_, vof0 + 128u, (unsigned)__builtin_amdgcn_readfirstlane(sb_ + AT_VOFF + (wid + 8) * 1024)); } while (0)
#ifdef AT_DMA_FIRST
    AT_DMA(NT - 1, 0); AT_DMA(NT - 2, 1); if (NT > 2) AT_DMA(NT - 3, 2);
#endif
    const bf16_t* Qw = PROJ + (rowbase + q0 + wq * 32 + r32) * LDP + P_QA + h * 128 + c * 64 + hi * 8;
    bf16x8 qr[4];
#pragma unroll
    for (int d0 = 0; d0 < 4; ++d0) qr[d0] = *(const bf16x8*)(Qw + d0 * 16);
    const float lam_init = 0.8f - 0.6f * expf(-0.3f * (float)l);
#ifndef AT_LAM_LATE
    const float* lamq = ARGP(6) + l * 256;
    const float lam = expf(wave_sum(lamq[lane] * lamq[64 + lane], lane)) - expf(wave_sum(lamq[128 + lane] * lamq[192 + lane], lane)) + lam_init;
#endif
#ifndef AT_DMA_FIRST
    if (!PRE) { AT_DMA(NT - 1, 0); AT_DMA(NT - 2, 1); if (NT > 2) AT_DMA(NT - 3, 2); }
#endif
    const float slope2 = exp2f(-2.f * (float)(h + 1)) * LOG2E;
    float s1 = slope2, s2 = 2.f * slope2, s3 = 3.f * slope2, s8 = 8.f * slope2, s32 = 32.f * slope2;
    asm volatile("" : "+v"(s1), "+v"(s2), "+v"(s3), "+v"(s8), "+v"(s32));
    const int qpos = q0 + wq * 32 + r32;
    LAS float* wsf = (LAS float*)(F.lds + WSF_OFF) + wid * 64;
    float mref = 0.f, lsum = 0.f;
    f32x16 o[4];
#pragma unroll
    for (int d0 = 0; d0 < 4; ++d0)
#pragma unroll
        for (int r = 0; r < 16; ++r) o[d0][r] = 0.f;
    const int trb = ((lane >> 4) & 1) * 32 + (lane & 3) * 8 + (4 * hi + ((lane & 15) >> 2)) * 64;
    int ka[4];
#pragma unroll
    for (int d0 = 0; d0 < 4; ++d0) ka[d0] = r32 * 256 + ((((8 * c + 2 * d0 + hi) ^ (r32 & 15))) << 4);
    if (NT > 2) AT_WAIT_BAR(4); else AT_WAIT_BAR(0);
    bf16x8 kf[8];
#pragma unroll
    for (int d0 = 0; d0 < 4; ++d0) { kf[2 * d0] = *(LAS const bf16x8*)(F.lds + ka[d0]); kf[2 * d0 + 1] = *(LAS const bf16x8*)(F.lds + ka[d0] + 8192); }
#ifdef AT_STAGGER
    if (c == 1) AT_WAIT_BAR_L();
#endif
#ifdef AT_CINIT
#define AT_CI(tt) do { const float u_ = slope2 * (float)(64 * (tt) + 4 * hi - qpos) - mref; \
        _Pragma("unroll") for (int g = 0; g < 4; ++g) { const float ug = u_ + s8 * (float)g; p0[4 * g] = ug; p0[4 * g + 1] = ug + s1; p0[4 * g + 2] = ug + s2; p0[4 * g + 3] = ug + s3; } \
        _Pragma("unroll") for (int r = 0; r < 16; ++r) p1[r] = p0[r] + s32; } while (0)
    f32x16 p0, p1;
    AT_CI(NT - 1);
#endif
    for (int i = 0; i < NT; ++i) {
        const int t = NT - 1 - i; const int slot = i & 3;
#if !defined(AT_STAGGER) && !defined(AT_X_NODMA)
        if (i + 3 < NT) AT_DMA(t - 3, (i + 3) & 3);
#endif
        LAS const unsigned char* sl = F.lds + slot * AT_SLOT;
        LAS const unsigned char* vb = sl + AT_VOFF + trb;
#ifndef AT_CINIT
        const float u = slope2 * (float)(64 * t + 4 * hi - qpos) - mref;
        f32x16 p0, p1;
#pragma unroll
        for (int g = 0; g < 4; ++g) { const float ug = u + s8 * (float)g;
            p0[4 * g] = ug; p0[4 * g + 1] = ug + s1; p0[4 * g + 2] = ug + s2; p0[4 * g + 3] = ug + s3; }
#pragma unroll
        for (int r = 0; r < 16; ++r) p1[r] = p0[r] + s32;
#endif
#pragma unroll
#ifndef AT_X_NOQK
        for (int d0 = 0; d0 < 4; ++d0) {
            p0 = __builtin_amdgcn_mfma_f32_32x32x16_bf16(kf[2 * d0], qr[d0], p0, 0, 0, 0);
            p1 = __builtin_amdgcn_mfma_f32_32x32x16_bf16(kf[2 * d0 + 1], qr[d0], p1, 0, 0, 0);
        }
#else
        for (int d0 = 0; d0 < 4; ++d0) { p0[d0] += __uint_as_float((unsigned)kf[2 * d0][0]); p1[d0] += __uint_as_float((unsigned)kf[2 * d0 + 1][0]); }
#endif
        bf16x8 vA[4], vB[4];
#pragma unroll
#ifdef AT_SPLIT
        for (int ks = 0; ks < 4; ++ks) vA[ks] = tr2(vb + (ks >> 1) * 4096 + (ks & 1) * 1024);
#else
        for (int ks = 0; ks < 4; ++ks) vA[ks] = tr2(vb + 0 * 4096 + ks * 1024);
#endif
#ifdef AT_FINE1
#pragma unroll
        for (int q = 0; q < 8; ++q) { __builtin_amdgcn_sched_group_barrier(0x008, 1, 0); __builtin_amdgcn_sched_group_barrier(0x100, 1, 0); }
#endif
        asm volatile("s_nop 15" : "+v"(p0), "+v"(p1));
        SBAR();
        if (64 * t + 63 > q0 + 32 * wq) {
            const int dq = qpos - 64 * t - 4 * hi;
#pragma unroll
            for (int r = 0; r < 16; ++r) { const int kr = (r & 3) + 8 * (r >> 2); if (kr > dq) p0[r] = -INFINITY; if (kr + 32 > dq) p1[r] = -INFINITY; }
        }
#ifndef AT_X_NOSM
        float ma = max3f(p0[0], p0[1], p1[0]), mb = max3f(p0[2], p0[3], p1[1]); ma = max3f(ma, p1[2], p1[3]);
#pragma unroll
        for (int r = 4; r < 16; r += 4) { ma = max3f(ma, p0[r], p0[r + 1]); mb = max3f(mb, p0[r + 2], p0[r + 3]); ma = max3f(ma, p1[r], p1[r + 1]); mb = max3f(mb, p1[r + 2], p1[r + 3]); }
        float rm = max2f(ma, mb);
        { auto rr = __builtin_amdgcn_permlane32_swap(__float_as_uint(rm), __float_as_uint(rm), false, false); rm = max2f(__uint_as_float(rr[0]), __uint_as_float(rr[1])); }
        if (__any(rm > (float)THR)) {
            const float dl = fmaxf(rm, 0.f); mref += dl;
#pragma unroll
            for (int r = 0; r < 16; ++r) { p0[r] -= dl; p1[r] -= dl; }
            const float f = ex2(-dl); lsum *= f;
            if (hi == 0) wsf[r32] = f;
            asm volatile("s_waitcnt lgkmcnt(0)" ::: "memory");
#pragma unroll
            for (int r = 0; r < 16; ++r) { const float fr = wsf[crow(r, hi)];
#pragma unroll
                for (int d0 = 0; d0 < 4; ++d0) o[d0][r] *= fr; }
            asm volatile("" ::: "memory");
        }
#ifndef AT_SPLIT
        float sa = 0.f, sb2 = 0.f;
#pragma unroll
        for (int r = 0; r < 16; ++r) { p0[r] = ex2(p0[r]); p1[r] = ex2(p1[r]); sa += p0[r]; sb2 += p1[r]; }
        lsum += sa + sb2;
#endif
#ifdef AT_SPLIT
        float sa = 0.f, sb2 = 0.f;
#pragma unroll
        for (int r = 0; r < 16; ++r) { p0[r] = ex2(p0[r]); sa += p0[r]; }
        u32x4 pw[4];
        pw[0] = (u32x4){cvtpk(p0[0], p0[1]), cvtpk(p0[2], p0[3]), cvtpk(p0[4], p0[5]), cvtpk(p0[6], p0[7])};
        pw[1] = (u32x4){cvtpk(p0[8], p0[9]), cvtpk(p0[10], p0[11]), cvtpk(p0[12], p0[13]), cvtpk(p0[14], p0[15])};
        SBAR();
        {
        LAS const unsigned char* sn = F.lds + ((i + 1) & 3) * AT_SLOT;
#define AT_V(d, k) tr2(vb + (d) * 4096 + (k) * 1024)
#define AT_PV(d, k, vf) o[d] = __builtin_amdgcn_mfma_f32_32x32x16_bf16(__builtin_bit_cast(bf16x8, pw[k]), vf, o[d], 0, 0, 0)
        bf16x8 vE[4], vF[4], vG[4];
        AT_PV(0, 0, vA[0]); vE[0] = AT_V(2, 0);
        AT_PV(0, 1, vA[1]); vE[1] = AT_V(2, 1);
        AT_PV(1, 0, vA[2]); vE[2] = AT_V(3, 0);
        AT_PV(1, 1, vA[3]); vE[3] = AT_V(3, 1);
        AT_PV(2, 0, vE[0]); vF[0] = AT_V(0, 2);
        AT_PV(2, 1, vE[1]); vF[1] = AT_V(0, 3);
        AT_PV(3, 0, vE[2]); vF[2] = AT_V(1, 2);
        AT_PV(3, 1, vE[3]); vF[3] = AT_V(1, 3);
#pragma unroll
        for (int r = 0; r < 16; ++r) { p1[r] = ex2(p1[r]); sb2 += p1[r]; }
        pw[2] = (u32x4){cvtpk(p1[0], p1[1]), cvtpk(p1[2], p1[3]), cvtpk(p1[4], p1[5]), cvtpk(p1[6], p1[7])};
        pw[3] = (u32x4){cvtpk(p1[8], p1[9]), cvtpk(p1[10], p1[11]), cvtpk(p1[12], p1[13]), cvtpk(p1[14], p1[15])};
        lsum += sa + sb2;
#pragma unroll
        for (int q = 0; q < 8; ++q) { __builtin_amdgcn_sched_group_barrier(0x008, 1, 0); __builtin_amdgcn_sched_group_barrier(0x100, 2, 0); __builtin_amdgcn_sched_group_barrier(0x400, 2, 0); __builtin_amdgcn_sched_group_barrier(0x002, AT_SPLIT, 0); }
        SBAR();
        AT_PV(0, 2, vF[0]); vG[0] = AT_V(2, 2);
        AT_PV(0, 3, vF[1]); vG[1] = AT_V(2, 3);
        AT_PV(1, 2, vF[2]); vG[2] = AT_V(3, 2);
        AT_PV(1, 3, vF[3]); vG[3] = AT_V(3, 3);
        AT_PV(2, 2, vG[0]); kf[0] = *(LAS const bf16x8*)(sn + ka[0]); kf[1] = *(LAS const bf16x8*)(sn + ka[0] + 8192);
        AT_PV(2, 3, vG[1]); kf[2] = *(LAS const bf16x8*)(sn + ka[1]); kf[3] = *(LAS const bf16x8*)(sn + ka[1] + 8192);
        AT_PV(3, 2, vG[2]); kf[4] = *(LAS const bf16x8*)(sn + ka[2]); kf[5] = *(LAS const bf16x8*)(sn + ka[2] + 8192);
        AT_PV(3, 3, vG[3]); kf[6] = *(LAS const bf16x8*)(sn + ka[3]); kf[7] = *(LAS const bf16x8*)(sn + ka[3] + 8192);
#pragma unroll
        for (int q = 0; q < 8; ++q) { __builtin_amdgcn_sched_group_barrier(0x008, 1, 0); __builtin_amdgcn_sched_group_barrier(0x100, 2, 0); }
        SBAR();
#undef AT_V
#undef AT_PV
        }
#endif
#else
        lsum += p0[0];
#endif
#ifndef AT_SPLIT
        u32x4 pw[4];
        pw[0] = (u32x4){cvtpk(p0[0], p0[1]), cvtpk(p0[2], p0[3]), cvtpk(p0[4], p0[5]), cvtpk(p0[6], p0[7])};
        pw[1] = (u32x4){cvtpk(p0[8], p0[9]), cvtpk(p0[10], p0[11]), cvtpk(p0[12], p0[13]), cvtpk(p0[14], p0[15])};
        pw[2] = (u32x4){cvtpk(p1[0], p1[1]), cvtpk(p1[2], p1[3]), cvtpk(p1[4], p1[5]), cvtpk(p1[6], p1[7])};
        pw[3] = (u32x4){cvtpk(p1[8], p1[9]), cvtpk(p1[10], p1[11]), cvtpk(p1[12], p1[13]), cvtpk(p1[14], p1[15])};
        SBAR();
#ifdef AT_STAGGER
        AT_WAIT_BAR_L();
        if (i + 3 < NT) AT_DMA(t - 3, (i + 3) & 3);
#endif
#ifndef AT_X_NOPV
#ifdef AT_FINE
        LAS const unsigned char* sn = F.lds + ((i + 1) & 3) * AT_SLOT;
        bf16x8 vC[4], vD[4];
#pragma unroll
        for (int ks = 0; ks < 4; ++ks) { o[0] = __builtin_amdgcn_mfma_f32_32x32x16_bf16(__builtin_bit_cast(bf16x8, pw[ks]), vA[ks], o[0], 0, 0, 0); vB[ks] = tr2(vb + 1 * 4096 + ks * 1024); }
#pragma unroll
        for (int ks = 0; ks < 4; ++ks) { o[1] = __builtin_amdgcn_mfma_f32_32x32x16_bf16(__builtin_bit_cast(bf16x8, pw[ks]), vB[ks], o[1], 0, 0, 0); vC[ks] = tr2(vb + 2 * 4096 + ks * 1024); }
#pragma unroll
        for (int ks = 0; ks < 4; ++ks) { o[2] = __builtin_amdgcn_mfma_f32_32x32x16_bf16(__builtin_bit_cast(bf16x8, pw[ks]), vC[ks], o[2], 0, 0, 0); vD[ks] = tr2(vb + 3 * 4096 + ks * 1024); }
#pragma unroll
        for (int ks = 0; ks < 4; ++ks) { o[3] = __builtin_amdgcn_mfma_f32_32x32x16_bf16(__builtin_bit_cast(bf16x8, pw[ks]), vD[ks], o[3], 0, 0, 0);
            kf[2 * ks] = *(LAS const bf16x8*)(sn + ka[ks]); kf[2 * ks + 1] = *(LAS const bf16x8*)(sn + ka[ks] + 8192); }
#ifdef AT_CINIT
        AT_CI(t - 1);
#pragma unroll
        for (int q = 0; q < 8; ++q) { __builtin_amdgcn_sched_group_barrier(0x008, 1, 0); __builtin_amdgcn_sched_group_barrier(0x100, 2, 0); }
#pragma unroll
        for (int q = 0; q < 8; ++q) { __builtin_amdgcn_sched_group_barrier(0x008, 1, 0); __builtin_amdgcn_sched_group_barrier(0x100, 2, 0); __builtin_amdgcn_sched_group_barrier(0x002, 4, 0); }
        asm volatile("" : "+v"(p0), "+v"(p1));
#else
#pragma unroll
        for (int q = 0; q < 16; ++q) { __builtin_amdgcn_sched_group_barrier(0x008, 1, 0); __builtin_amdgcn_sched_group_barrier(0x100, 2, 0); }
#endif
        SBAR();
#else
        const bool more = (i + 1 < NT);
        LAS const unsigned char* sn = F.lds + ((i + 1) & 3) * AT_SLOT;
#pragma unroll
        for (int ks = 0; ks < 4; ++ks) vB[ks] = tr2(vb + 1 * 4096 + ks * 1024);
#pragma unroll
        for (int ks = 0; ks < 4; ++ks) o[0] = __builtin_amdgcn_mfma_f32_32x32x16_bf16(__builtin_bit_cast(bf16x8, pw[ks]), vA[ks], o[0], 0, 0, 0);
        if (more) {
#pragma unroll
            for (int d0 = 0; d0 < 2; ++d0) { kf[2 * d0] = *(LAS const bf16x8*)(sn + ka[d0]); kf[2 * d0 + 1] = *(LAS const bf16x8*)(sn + ka[d0] + 8192); } }
        SBAR();
        bf16x8 vC[4], vD[4];
#pragma unroll
        for (int ks = 0; ks < 4; ++ks) vC[ks] = tr2(vb + 2 * 4096 + ks * 1024);
#pragma unroll
        for (int ks = 0; ks < 4; ++ks) o[1] = __builtin_amdgcn_mfma_f32_32x32x16_bf16(__builtin_bit_cast(bf16x8, pw[ks]), vB[ks], o[1], 0, 0, 0);
        if (more) {
#pragma unroll
            for (int d0 = 2; d0 < 4; ++d0) { kf[2 * d0] = *(LAS const bf16x8*)(sn + ka[d0]); kf[2 * d0 + 1] = *(LAS const bf16x8*)(sn + ka[d0] + 8192); } }
        SBAR();
#pragma unroll
        for (int ks = 0; ks < 4; ++ks) vD[ks] = tr2(vb + 3 * 4096 + ks * 1024);
#pragma unroll
        for (int ks = 0; ks < 4; ++ks) o[2] = __builtin_amdgcn_mfma_f32_32x32x16_bf16(__builtin_bit_cast(bf16x8, pw[ks]), vC[ks], o[2], 0, 0, 0);
        SBAR();
#pragma unroll
        for (int ks = 0; ks < 4; ++ks) o[3] = __builtin_amdgcn_mfma_f32_32x32x16_bf16(__builtin_bit_cast(bf16x8, pw[ks]), vD[ks], o[3], 0, 0, 0);
#endif
#else
        o[0][0] += __uint_as_float(pw[0].x) + __uint_as_float(pw[1].y) + __uint_as_float(pw[2].z) + __uint_as_float(pw[3].w) + __uint_as_float((unsigned)vA[0][0]);
#endif
#endif
#if defined(AT_X_NOBAR)
        asm volatile("s_waitcnt vmcnt(0) lgkmcnt(0)" ::: "memory");
#elif defined(AT_X_NODMA)
        AT_WAIT_BAR(0);
#elif defined(AT_NOLGKM)
        if (i + 3 < NT) asm volatile("s_waitcnt vmcnt(4)\n\ts_barrier" ::: "memory"); else asm volatile("s_waitcnt vmcnt(0)\n\ts_barrier" ::: "memory");
#else
        if (i + 3 < NT) AT_WAIT_BAR(4); else AT_WAIT_BAR(0);
#endif
    }
#ifdef AT_STAGGER
    if (c == 0) AT_WAIT_BAR_L();
#endif
#ifdef AT_EPI2
    int le = lane; asm volatile("" : "+v"(le));
    const int e_r32 = le & 31, e_hi = le >> 5;
    u32x4 zr[4];
    { const bf16_t* pz = PROJ + (rowbase + q0 + wq * 32 + 16 * c + (le >> 4)) * LDP + h * 128 + (le & 15) * 8 + P_ZA;
#pragma unroll
      for (int ps = 0; ps < 4; ++ps) zr[ps] = *(const u32x4*)(pz + (size_t)ps * 4 * LDP); }
    float lq0, lq1, lq2, lq3;
    { const float* lamq = ARGP(6) + l * 256; lq0 = lamq[le]; lq1 = lamq[64 + le]; lq2 = lamq[128 + le]; lq3 = lamq[192 + le]; }
    f32x4 g0, g1;
    { const float* nap = ARGP(7) + l * 512 + h * 128 + (le & 15) * 8; g0 = *(const f32x4*)nap; g1 = *(const f32x4*)(nap + 4); }
    lsum = half_swap_add(lsum);
    if (e_hi == 0) wsf[32 + e_r32] = rcp(lsum);
    asm volatile("s_waitcnt lgkmcnt(0)" ::: "memory");
    LAS float* XW = (LAS float*)(F.lds) + (c * 4 + wq) * 2048;
    LAS float* XR = (LAS float*)(F.lds) + ((1 - c) * 4 + wq) * 2048;
    LAS float* ST = (LAS float*)(F.lds + 65536) + (c * 4 + wq) * 2048;
#define EPI_SEND(OB) do { _Pragma("unroll") for (int rr = 0; rr < 8; ++rr) { const float rlr = wsf[32 + crow((OB) + rr, e_hi)]; \
        _Pragma("unroll") for (int d0 = 0; d0 < 4; ++d0) XW[(d0 * 8 + rr) * 64 + le] = o[d0][(OB) + rr] * rlr; } } while (0)
    if (c == 0) EPI_SEND(8); else EPI_SEND(0);
#undef EPI_SEND
    AT_WAIT_BAR(0);
    const float lam = expf(wave_sum(lq0 * lq1, le)) - expf(wave_sum(lq2 * lq3, le)) + lam_init;
    const float kown = c == 0 ? 1.f : -lam, kpar = c == 0 ? -lam : 1.f;
#define EPI_FIN(RB) do { _Pragma("unroll") for (int rr = 0; rr < 8; ++rr) { float ss = 0.f; const float rlr = wsf[32 + crow((RB) + rr, e_hi)] * kown; \
        _Pragma("unroll") for (int d0 = 0; d0 < 4; ++d0) { const float v = o[d0][(RB) + rr] * rlr + kpar * XR[(d0 * 8 + rr) * 64 + le]; o[d0][(RB) + rr] = v; ss += v * v; } \
        ss += bperm(ss, le ^ 1); ss += bperm(ss, le ^ 2); ss += bperm(ss, le ^ 4); ss += bperm(ss, le ^ 8); ss += bperm(ss, le ^ 16); \
        const float rs = rsqrtf(ss * (1.f / 128.f) + EPS) * (1.f - lam_init); \
        _Pragma("unroll") for (int d0 = 0; d0 < 4; ++d0) ST[crow(rr, e_hi) * 128 + d0 * 32 + e_r32] = o[d0][(RB) + rr] * rs; } } while (0)
    if (c == 0) EPI_FIN(0); else EPI_FIN(8);
#undef EPI_FIN
    asm volatile("s_waitcnt lgkmcnt(0)" ::: "memory");
    { const int ch = le & 15;
      bf16_t* pr0 = PROJ + (rowbase + q0 + wq * 32 + 16 * c + (le >> 4)) * LDP + h * 128 + ch * 8;
#pragma unroll
      for (int ps = 0; ps < 4; ++ps) {
          const int row = ps * 4 + (le >> 4);
          const f32x4 v0 = *(LAS const f32x4*)(ST + row * 128 + ch * 8), v1 = *(LAS const f32x4*)(ST + row * 128 + ch * 8 + 4);
          bf16_t* pr = pr0 + (size_t)ps * 4 * LDP;
          const u32x4 z = zr[ps];
          u32x4 w;
          w.x = cvtpk(v0[0] * g0[0] * silu(bflo(z.x)), v0[1] * g0[1] * silu(bfhi(z.x)));
          w.y = cvtpk(v0[2] * g0[2] * silu(bflo(z.y)), v0[3] * g0[3] * silu(bfhi(z.y)));
          w.z = cvtpk(v1[0] * g1[0] * silu(bflo(z.z)), v1[1] * g1[1] * silu(bfhi(z.z)));
          w.w = cvtpk(v1[2] * g1[2] * silu(bflo(z.w)), v1[3] * g1[3] * silu(bfhi(z.w)));

#ifdef HO_AMG
          st16_wt(F.ws, (size_t)((unsigned char*)(pr + P_YA) - F.ws), w);
#else
          *(u32x4*)(pr + P_YA) = w;
#endif

      } }
    AT_WAIT_BAR(0);
#else
    int le = lane; asm volatile("" : "+v"(le));
    const int e_r32 = le & 31, e_hi = le >> 5;
#ifdef AT_ZPRE
    u32x4 zr[8];
    if (c == 0) {
        const bf16_t* pz = PROJ + (rowbase + q0 + wq * 32 + (le >> 4)) * LDP + h * 128 + (le & 15) * 8 + P_ZA;
#pragma unroll
        for (int ps = 0; ps < 8; ++ps) zr[ps] = *(const u32x4*)(pz + (size_t)ps * 4 * LDP);
    }
#ifdef AT_LAM_LATE
    float lq0, lq1, lq2, lq3;
    { const float* lamq = ARGP(6) + l * 256; lq0 = lamq[le]; lq1 = lamq[64 + le]; lq2 = lamq[128 + le]; lq3 = lamq[192 + le]; }
#endif
    f32x4 g0p = {0.f, 0.f, 0.f, 0.f}, g1p = g0p;
    if (c == 0) { const float* nap = ARGP(7) + l * 512 + h * 128 + (le & 15) * 8; g0p = *(const f32x4*)nap; g1p = *(const f32x4*)(nap + 4); }
#endif
    lsum = half_swap_add(lsum);
    if (e_hi == 0) wsf[32 + e_r32] = rcp(lsum);
    asm volatile("s_waitcnt lgkmcnt(0)" ::: "memory");
    LAS float* X = (LAS float*)(F.lds) + wq * 4096;
    if (c == 1) {
#pragma unroll
        for (int r = 0; r < 16; ++r) { const float rlr = wsf[32 + crow(r, e_hi)];
#pragma unroll
            for (int d0 = 0; d0 < 4; ++d0) X[(d0 * 16 + r) * 64 + le] = o[d0][r] * rlr; }
    }
    AT_WAIT_BAR(0);
    if (c == 0) {
#ifdef AT_LAM_LATE
        const float lam = expf(wave_sum(lq0 * lq1, le)) - expf(wave_sum(lq2 * lq3, le)) + lam_init;
#endif
        LAS float* ST = (LAS float*)(F.lds + 65536) + wq * 4096;
#pragma unroll
        for (int r = 0; r < 16; ++r) { float ss = 0.f; const float rlr = wsf[32 + crow(r, e_hi)];
#pragma unroll
            for (int d0 = 0; d0 < 4; ++d0) { const float v = o[d0][r] * rlr - lam * X[(d0 * 16 + r) * 64 + le]; o[d0][r] = v; ss += v * v; }
            ss += bperm(ss, le ^ 1); ss += bperm(ss, le ^ 2); ss += bperm(ss, le ^ 4); ss += bperm(ss, le ^ 8); ss += bperm(ss, le ^ 16);
            const float rs = rsqrtf(ss * (1.f / 128.f) + EPS) * (1.f - lam_init);
#pragma unroll
            for (int d0 = 0; d0 < 4; ++d0) ST[crow(r, e_hi) * 128 + d0 * 32 + e_r32] = o[d0][r] * rs; }
        asm volatile("s_waitcnt lgkmcnt(0)" ::: "memory");
        const int ch = le & 15;
        const float* na = ARGP(7) + l * 512 + h * 128 + ch * 8;
#ifdef AT_ZPRE
        const f32x4 g0 = g0p, g1 = g1p; (void)na;
#else
        const f32x4 g0 = *(const f32x4*)na, g1 = *(const f32x4*)(na + 4);
#endif
        bf16_t* pr0 = PROJ + (rowbase + q0 + wq * 32 + (le >> 4)) * LDP + h * 128 + ch * 8;
#ifdef AT_ZPRE
#pragma unroll
#else
#pragma unroll 2
#endif
        for (int ps = 0; ps < 8; ++ps) {
            const int row = ps * 4 + (le >> 4);
            const f32x4 v0 = *(LAS const f32x4*)(ST + row * 128 + ch * 8), v1 = *(LAS const f32x4*)(ST + row * 128 + ch * 8 + 4);
            bf16_t* pr = pr0 + (size_t)ps * 4 * LDP;
#ifdef AT_ZPRE
            const u32x4 z = zr[ps];
#else
            const u32x4 z = *(const u32x4*)(pr + P_ZA);
#endif
            u32x4 w;
            w.x = cvtpk(v0[0] * g0[0] * silu(bflo(z.x)), v0[1] * g0[1] * silu(bfhi(z.x)));
            w.y = cvtpk(v0[2] * g0[2] * silu(bflo(z.y)), v0[3] * g0[3] * silu(bfhi(z.y)));
            w.z = cvtpk(v1[0] * g1[0] * silu(bflo(z.z)), v1[1] * g1[1] * silu(bfhi(z.z)));
            w.w = cvtpk(v1[2] * g1[2] * silu(bflo(z.w)), v1[3] * g1[3] * silu(bfhi(z.w)));

#ifdef HO_AMG
          st16_wt(F.ws, (size_t)((unsigned char*)(pr + P_YA) - F.ws), w);
#else
          *(u32x4*)(pr + P_YA) = w;
#endif

        }
    }
    AT_WAIT_BAR(0);
#endif
#undef AT_DMA
}

__device__ __forceinline__ void attn_prefetch(Frame& F, int b, int h, int qb) {
    int lane_ = F.lane; asm volatile("" : "+v"(lane_));
    const int lane = lane_, wid = F.wave;
    const bf16_t* PROJ = (const bf16_t*)(F.ws + WS_PROJ);
    const int NT = 2 * (qb + 1);
    const unsigned lds0 = (unsigned)(uintptr_t)F.lds;
    const int kr0 = 8 * wid + (lane >> 4), kr1 = kr0 + 4;
    const unsigned kof0 = (unsigned)(kr0 * LDP + P_KA + h * 128 + ((lane & 15) ^ (kr0 & 15)) * 8) * 2u;
    const unsigned kof1 = (unsigned)(kr1 * LDP + P_KA + h * 128 + ((lane & 15) ^ (kr1 & 15)) * 8) * 2u;
    const unsigned vof0 = (unsigned)(((lane >> 2) + 16 * (wid & 3)) * LDP + P_VA + h * 128 + (lane & 3) * 8 + (wid >> 2) * 32) * 2u;
    const bf16_t* KVb = PROJ + (size_t)b * SEQ * LDP;
#define AT_DMA_P(t, slot) do { const bf16_t* tb_ = KVb + (size_t)(t) * 64 * LDP; const unsigned sb_ = lds0 + (unsigned)(slot) * AT_SLOT; \
        glds16s(tb_, kof0, (unsigned)__builtin_amdgcn_readfirstlane(sb_ + wid * 2048)); \
        glds16s(tb_, kof1, (unsigned)__builtin_amdgcn_readfirstlane(sb_ + wid * 2048 + 1024)); \
        glds16s(tb_, vof0, (unsigned)__builtin_amdgcn_readfirstlane(sb_ + AT_VOFF + wid * 1024)); \
        glds16s(tb_, vof0 + 128u, (unsigned)__builtin_amdgcn_readfirstlane(sb_ + AT_VOFF + (wid + 8) * 1024)); } while (0)
    AT_DMA_P(NT - 1, 0); AT_DMA_P(NT - 2, 1); if (NT > 2) AT_DMA_P(NT - 3, 2);
#undef AT_DMA_P
}

#ifdef HO_M123
#define WT_ST32(p, x) __hip_atomic_store((unsigned*)(p), (unsigned)(x), __ATOMIC_RELAXED, __HIP_MEMORY_SCOPE_AGENT)
#define WT_STF(p, x)  __hip_atomic_store((unsigned*)(p), __float_as_uint(x), __ATOMIC_RELAXED, __HIP_MEMORY_SCOPE_AGENT)
constexpr int CW_F1 = 3072, CW_F2 = 3584;
__device__ __forceinline__ void ho_publish(Frame& F, int word) {
    asm volatile("s_waitcnt vmcnt(0)" ::: "memory"); __syncthreads();
    if (is_t0(F.wave)) __hip_atomic_store((unsigned*)(F.ws + WS_CTL) + word, 1u, __ATOMIC_RELAXED, __HIP_MEMORY_SCOPE_AGENT);
}
template <int N, bool ACQ = true> __device__ __forceinline__ void ho_wait(Frame& F, int word0) {
    if (F.wave == 0) { const int ln = lane_now(); unsigned* pf = (unsigned*)(F.ws + WS_CTL) + word0; unsigned sp_ = 0;
        for (;;) { bool ok = true;
#pragma unroll
            for (int k = 0; k < (N + 63) / 64; ++k) { const int i = ln + 64 * k; if (i < N) ok = ok && (xb_ld(pf + i) != 0u); }
            if (__all(ok)) break; __builtin_amdgcn_s_sleep(1); if (++sp_ > XB_SPIN_CAP) break; }
        if (ACQ && ln == 0) { __builtin_amdgcn_fence(__ATOMIC_ACQUIRE, "agent"); asm volatile("s_waitcnt vmcnt(0)" ::: "memory"); } }
    __syncthreads();
}
constexpr int CW_AM = 7552;
struct AllAM { unsigned char* ws; int word0; static constexpr bool ON = true, MID = false;
    __device__ __forceinline__ void operator()(int wid) const { if (wid == 0) { const int ln = lane_now(); unsigned* pf = (unsigned*)(ws + WS_CTL) + word0; unsigned sp_ = 0;
        for (;;) { bool ok = true;
#pragma unroll
            for (int k = 0; k < 4; ++k) ok = ok && (xb_ld(pf + ln + 64 * k) != 0u);
            if (__all(ok)) break; __builtin_amdgcn_s_sleep(1); if (++sp_ > XB_SPIN_CAP) break; }
        asm volatile("s_waitcnt vmcnt(0)" ::: "memory"); } } };
constexpr int CW_NF = 8448;
struct AllN { unsigned char* ws; static constexpr bool ON = true, MID = true;
    __device__ __forceinline__ void operator()(int wid) const { if (wid == 0) { const int ln = lane_now(); unsigned* pf = (unsigned*)(ws + WS_CTL) + CW_NF; unsigned sp_ = 0;
        for (;;) { bool ok = true;
#pragma unroll
            for (int k = 0; k < 4; ++k) ok = ok && (xb_ld(pf + ln + 64 * k) != 0u);
            if (__all(ok)) break; __builtin_amdgcn_s_sleep(1); if (++sp_ > XB_SPIN_CAP) break; }
        if (ln == 0) { __builtin_amdgcn_fence(__ATOMIC_ACQUIRE, "agent"); asm volatile("s_waitcnt vmcnt(0)" ::: "memory"); } } } };
#ifdef HO_G1
constexpr int CW_G1 = 256;
__device__ __forceinline__ void ho_wait_m1(Frame& F, int l) {
    if (F.wave == 0) { const int ln = lane_now();
        const int bh = F.vcu >> 4, j = F.vcu & 15, bb = bh >> 2, h = bh & 3;
        const int pm = bb * 16 + j, pnK = 10 + (h >> 1), pnV = 12 + (h >> 1);
        const int sel = ln >> 1, which = ln & 1;
        const bool need = ln < 6 && !(sel == 2 && j == 0);
        const int pmt = sel == 2 ? pm - 1 : pm, pnt = sel == 1 ? pnV : pnK;
        const int wgid = (pmt >> 2) * (WGM * (NLA / BM)) + pnt * WGM + (pmt & 3), q_ = (M / BM) * (NLA / BM) / NXCD, L = (wgid % q_) * NXCD + wgid / q_;
        const int prod = L < 4 * 256 ? (L & 255) : 2 * (L - 4 * 256) + which;
#ifdef HO_G1EARLY
        unsigned* pf = (unsigned*)(F.ws + WS_CTL) + (L < 4 * 256 ? (l == 0 ? 768 : 1664) : CW_G1 + 256 * l) + (need ? prod : 0); unsigned sp_ = 0;
#else
        unsigned* pf = (unsigned*)(F.ws + WS_CTL) + CW_G1 + 256 * l + (need ? prod : 0); unsigned sp_ = 0;
#endif
        for (;;) { const bool ok = !need || xb_ld(pf) != 0u; if (__all(ok)) break; __builtin_amdgcn_s_sleep(1); if (++sp_ > XB_SPIN_CAP) break; }
#ifndef HO_NOACQ
        if (ln == 0) { __builtin_amdgcn_fence(__ATOMIC_ACQUIRE, "agent"); asm volatile("s_waitcnt vmcnt(0)" ::: "memory"); }
#endif
        }
    __syncthreads();
}
#endif
#else
#define WT_ST32(p, x) (*(unsigned*)(p) = (unsigned)(x))
#define WT_STF(p, x)  (*(float*)(p) = (x))
#endif
#define LDS_BAR() asm volatile("s_waitcnt lgkmcnt(0)\n\ts_barrier" ::: "memory")
#define LDS_BAR_() asm volatile("s_waitcnt lgkmcnt(0)\n\ts_barrier" ::: "memory")
__device__ __forceinline__ float logsig(float x) { return fminf(x, 0.f) - __builtin_amdgcn_logf(1.f + ex2(-fabsf(x) * LOG2E)) * 0.6931471805599453f; }
__device__ __forceinline__ float fexp(float x) { return ex2(x * LOG2E); }
template <int CTRL, int ROWMASK> __device__ __forceinline__ float dpp_f(float ident, float v) {
    return __uint_as_float((unsigned)__builtin_amdgcn_update_dpp((int)__float_as_uint(ident), (int)__float_as_uint(v), CTRL, ROWMASK, 0xF, false)); }
__device__ __forceinline__ float wave_prefix_sum(float v, int) {
    v += dpp_f<0x111, 0xF>(0.f, v); v += dpp_f<0x112, 0xF>(0.f, v); v += dpp_f<0x114, 0xF>(0.f, v); v += dpp_f<0x118, 0xF>(0.f, v);
    v += dpp_f<0x142, 0xA>(0.f, v); v += dpp_f<0x143, 0xC>(0.f, v);
    return v;
}
__device__ __forceinline__ float wave_prefix_max(float v, int) {
    const float NI = -INFINITY;
    v = fmaxf(v, dpp_f<0x111, 0xF>(NI, v)); v = fmaxf(v, dpp_f<0x112, 0xF>(NI, v)); v = fmaxf(v, dpp_f<0x114, 0xF>(NI, v)); v = fmaxf(v, dpp_f<0x118, 0xF>(NI, v));
    v = fmaxf(v, dpp_f<0x142, 0xA>(NI, v)); v = fmaxf(v, dpp_f<0x143, 0xC>(NI, v));
    return v;
}
__device__ __forceinline__ float wave_max(float v, int lane) { return __uint_as_float((unsigned)__builtin_amdgcn_readlane((int)__float_as_uint(wave_prefix_max(v, lane)), 63)); }
__device__ __forceinline__ void conv8(const bf16_t* PROJ, long row0, bool first, int pcol, const float* cw, int cp, int rg, float (&y)[8][2]) {
    float x[11][2];
#pragma unroll
    for (int i = 0; i < 11; ++i) { const int rr = 8 * rg + i - 3;
        unsigned w = 0u; if (!(first && rr < 0)) w = *(const unsigned*)(PROJ + (row0 + rr) * LDP + pcol + 2 * cp);
        x[i][0] = bflo(w); x[i][1] = bfhi(w); }
    float wt[4][2];
#pragma unroll
    for (int k = 0; k < 4; ++k) { const f32x2 t = *(const f32x2*)(cw + k * 1024 + 2 * cp); wt[k][0] = t[0]; wt[k][1] = t[1]; }
#pragma unroll
    for (int r = 0; r < 8; ++r)
#pragma unroll
        for (int e = 0; e < 2; ++e) { float a = wt[0][e] * x[r][e]; a += wt[1][e] * x[r + 1][e]; a += wt[2][e] * x[r + 2][e]; a += wt[3][e] * x[r + 3][e]; y[r][e] = silu(a); }
}

struct M1Pre { u32x4 v[2]; unsigned k[11]; float ig, fg; };
__device__ __forceinline__ void conv_load(const bf16_t* PROJ, long row0, bool first, int pcol, int cp, int rg, unsigned (&x)[11]);
__device__ __forceinline__ void conv_calc(const unsigned (&x)[11], const float (&wt)[4][2], float (&y)[8][2]);
__device__ __forceinline__ void m1_load(Frame& F, int item, int tid, M1Pre& P) {
    const int lane = tid & 63;
    const int bh = item >> 6, ch = item & 63, b = bh >> 2, h = bh & 3; const long row0 = (long)b * SEQ + ch * 64;
    const bf16_t* PROJ = (const bf16_t*)(F.ws + WS_PROJ);
#pragma unroll
    for (int ps = 0; ps < 2; ++ps) { const int row = (tid >> 4) + 32 * ps, chk = tid & 15; P.v[ps] = *(const u32x4*)(PROJ + (row0 + row) * LDP + P_VB + h * 128 + chk * 8); }
    conv_load(PROJ, row0, ch == 0, P_KB + h * 128, tid & 63, tid >> 6, P.k);
    P.ig = 0.f; P.fg = 0.f;
#ifdef M1_NOBAR1
    { const float* GATES = (const float*)(F.ws + WS_GATES); P.ig = GATES[(row0 + lane) * 8 + h]; P.fg = GATES[(row0 + lane) * 8 + 4 + h]; }
#else
    if (F.wave == 0) { const float* GATES = (const float*)(F.ws + WS_GATES); P.ig = GATES[(row0 + lane) * 8 + h]; P.fg = GATES[(row0 + lane) * 8 + 4 + h]; }
#endif
}
__device__ __forceinline__ void mlstm1_run(Frame& F, int l, int item0) {
    int tid0 = F.tid; asm volatile("" : "+v"(tid0));
    const int wave = F.wave, h = (item0 >> 6) & 3;
    LAS unsigned char* KW = F.lds; LAS unsigned char* VT = F.lds + 16384; LAS unsigned char* STG = F.lds + 32768; LAS float* wk = (LAS float*)(F.lds + 69632);
    float* MSC = (float*)(F.ws + WS_MSC);
    float wt[4][2];
    { const float* cw = ARGP(5) + (size_t)l * 4096 + 512 + h * 128 + 2 * (tid0 & 63);
#pragma unroll
      for (int k = 0; k < 4; ++k) { const f32x2 t = *(const f32x2*)(cw + k * 1024); wt[k][0] = t[0]; wt[k][1] = t[1]; } }
    const float bi = ARGP(4)[l * 8 + h], bf_ = ARGP(4)[l * 8 + 4 + h];
    M1Pre P;
    m1_load(F, item0, tid0, P);
#pragma unroll 1
    for (int it = 0; it < 4; ++it) {
        const int item = item0 + it;
        int tid = tid0; asm volatile("" : "+v"(tid));
        int lane = tid & 63; const int cp = tid & 63, rg = tid >> 6;
#ifdef M1_NOBAR1
        float wkv;
        { const float bs = wave_prefix_sum(logsig(P.fg + bf_), lane), bL = __uint_as_float((unsigned)__builtin_amdgcn_readlane((int)__float_as_uint(bs), 63));
          const float a = bL - bs + P.ig + bi, ml = wave_max(a, lane);
          wkv = fexp(a - ml) * KSCALE;
          if (wave == 0 && lane == 0) { WT_STF(MSC + item, bL); WT_STF(MSC + 1024 + item, ml); } }
        float y[8][2];
        conv_calc(P.k, wt, y);
#pragma unroll
        for (int r = 0; r < 8; ++r) { const int s = 8 * rg + r, d = 2 * cp; const float w = __uint_as_float((unsigned)__builtin_amdgcn_readlane((int)__float_as_uint(wkv), 8 * wave + r));
#else
        if (wave == 0) {
            const float bs = wave_prefix_sum(logsig(P.fg + bf_), lane), bL = __uint_as_float((unsigned)__builtin_amdgcn_readlane((int)__float_as_uint(bs), 63));
            const float a = bL - bs + P.ig + bi, ml = wave_max(a, lane);
            wk[lane] = fexp(a - ml) * KSCALE;
            if (lane == 0) { MSC[item] = bL; MSC[1024 + item] = ml; }
        }
        float y[8][2];
        conv_calc(P.k, wt, y);
        LDS_BAR();
#pragma unroll
        for (int r = 0; r < 8; ++r) { const int s = 8 * rg + r, d = 2 * cp; const float w = wk[s];
#endif
            *(LAS unsigned*)(KW + (d >> 5) * 4096 + (s >> 4) * 1024 + (s & 15) * 64 + (d & 31) * 2) = cvtpk(y[r][0] * w, y[r][1] * w); }
#pragma unroll
        for (int ps = 0; ps < 2; ++ps) { const int row = (tid >> 4) + 32 * ps, chk = tid & 15;
            *(LAS u32x4*)(VT + (chk >> 2) * 4096 + (row >> 4) * 1024 + (row & 15) * 64 + (chk & 3) * 16) = P.v[ps]; }
        LDS_BAR();
        asm volatile("" : "+v"(tid)); lane = tid & 63;
        const int hi = lane >> 5, r32 = lane & 31;
        if (it + 1 < 4) m1_load(F, item + 1, tid, P);
#ifdef M1_DN4
        { const int d = tid >> 2, part = tid & 3; float a = 0.f;
#pragma unroll
            for (int s = 0; s < 16; ++s) a += bf1(*(LAS const bf16_t*)(KW + (d >> 5) * 4096 + part * 1024 + s * 64 + (d & 31) * 2));
            a += dpp_f<0xB1, 0xF>(0.f, a); a += dpp_f<0x4E, 0xF>(0.f, a);
            if (part == 0) WT_STF((float*)(F.ws + WS_DN) + (size_t)item * 128 + d, a); }
#else
        if (tid < 128) { const int d = tid; float a = 0.f;
#pragma unroll 8
            for (int s = 0; s < 64; ++s) a += bf1(*(LAS const bf16_t*)(KW + (d >> 5) * 4096 + (s >> 4) * 1024 + (s & 15) * 64 + (d & 31) * 2));
            ((float*)(F.ws + WS_DN))[(size_t)item * 128 + d] = a; }
#endif
        const int db = wave >> 1, eb0 = 2 * (wave & 1);
        const int trb = ((lane >> 4) & 1) * 32 + (lane & 3) * 8 + (4 * hi + ((lane & 15) >> 2)) * 64;
        f32x16 acc[2];
#pragma unroll
        for (int r = 0; r < 16; ++r) { acc[0][r] = 0.f; acc[1][r] = 0.f; }
#pragma unroll
        for (int ks = 0; ks < 4; ++ks) {
            const bf16x8 a = tr2(KW + db * 4096 + ks * 1024 + trb);
            const bf16x8 b0 = tr2(VT + eb0 * 4096 + ks * 1024 + trb), b1 = tr2(VT + (eb0 + 1) * 4096 + ks * 1024 + trb);
#ifdef M1_SWAP
            acc[0] = __builtin_amdgcn_mfma_f32_32x32x16_bf16(b0, a, acc[0], 0, 0, 0);
            acc[1] = __builtin_amdgcn_mfma_f32_32x32x16_bf16(b1, a, acc[1], 0, 0, 0);
#else
            acc[0] = __builtin_amdgcn_mfma_f32_32x32x16_bf16(a, b0, acc[0], 0, 0, 0);
            acc[1] = __builtin_amdgcn_mfma_f32_32x32x16_bf16(a, b1, acc[1], 0, 0, 0);
#endif
        }
#ifdef M1_SWAP
        constexpr int SPITCH = 272;
#pragma unroll
        for (int i = 0; i < 2; ++i)
#pragma unroll
            for (int g = 0; g < 4; ++g) { const int d = 32 * db + r32, e = 32 * (eb0 + i) + 8 * g + 4 * hi;
                *(LAS u32x2*)(STG + d * SPITCH + e * 2) = (u32x2){cvtpk(acc[i][4 * g], acc[i][4 * g + 1]), cvtpk(acc[i][4 * g + 2], acc[i][4 * g + 3])}; }
        LDS_BAR();
        bf16_t* CST = (bf16_t*)(F.ws + WS_CST) + (size_t)item * 16384;
#pragma unroll
#ifdef HO_M123
        for (int j = 0; j < 4; ++j) { const int idx = tid + 512 * j;
            __builtin_amdgcn_raw_buffer_store_b128(*(LAS const u32x4*)(STG + (idx >> 4) * SPITCH + (idx & 15) * 16), __builtin_amdgcn_make_buffer_rsrc((void*)(F.ws + WS_CST), 0, 33554432, 0x00020000),
                                                   (unsigned)(item * 32768 + idx * 16), 0, 16); (void)CST; }
#else
        for (int j = 0; j < 4; ++j) { const int idx = tid + 512 * j; *(u32x4*)(CST + idx * 8) = *(LAS const u32x4*)(STG + (idx >> 4) * SPITCH + (idx & 15) * 16); }
#endif
#else
#pragma unroll
        for (int i = 0; i < 2; ++i)
#pragma unroll
            for (int r = 0; r < 16; ++r) { const int d = 32 * db + crow(r, hi), e = 32 * (eb0 + i) + r32;
                *(LAS bf16_t*)(STG + d * 256 + e * 2) = (bf16_t)(cvtpk(acc[i][r], 0.f) & 0xffffu); }
        LDS_BAR();
        bf16_t* CST = (bf16_t*)(F.ws + WS_CST) + (size_t)item * 16384;
#pragma unroll
        for (int j = 0; j < 4; ++j) { const int idx = tid + 512 * j; *(u32x4*)(CST + idx * 8) = *(LAS const u32x4*)(STG + idx * 16); }
#endif
    }
#ifdef HO_M123
    ho_publish(F, CW_F1 + 256 * l + F.vcu);
#else
    LDS_BAR();
#endif
}

#ifndef SC_B
#define SC_B 21
#endif
__device__ __forceinline__ void mlstm_scan(Frame& F, int l = 0) {
    int tid_ = F.tid; asm volatile("" : "+v"(tid_));
    const int bh = F.vcu >> 4, part = F.vcu & 15, tid = tid_;
    if (bh >= 16) return;
#ifdef HO_M123
#ifdef HO_G1
    if (F.wave == 0) { const int ln = lane_now(); unsigned* pg = (unsigned*)(F.ws + WS_CTL) + CW_G1 + 256 * l; bool okg = true;
#pragma unroll
        for (int k = 0; k < 4; ++k) okg = okg && (xb_ld(pg + ln + 64 * k) != 0u);
        const bool allg = __all(okg); if (ln == 0) ((volatile LAS unsigned*)(F.lds + MISC_OFF))[26] = allg ? 1u : 0u; }
#endif
#ifdef HO_NOACQ
    ho_wait<16, false>(F, CW_F1 + 256 * l + 16 * bh);
#else
    ho_wait<16>(F, CW_F1 + 256 * l + 16 * bh);
#endif
#endif
    const float* MSC = (const float*)(F.ws + WS_MSC); float* MST = (float*)(F.ws + WS_MSC) + 2048;
#ifdef AT_PREFETCH
    LAS float* sbl = (LAS float*)(F.lds + WSF_OFF);
#else
    LAS float* sbl = (LAS float*)F.lds;
#endif
    LAS float* sml = sbl + 64; LAS float* sm = sbl + 128; LAS float* sf = sbl + 256; LAS float* sg = sbl + 320;
    if (tid < 64) {
        const float bl = MSC[bh * 64 + tid], ml = MSC[1024 + bh * 64 + tid];
        float A = bl, B = ml;
#define MP_STEP(CTRL, RM) do { const float Ap = dpp_f<CTRL, RM>(0.f, A), Bp = dpp_f<CTRL, RM>(-INFINITY, B); B = fmaxf(Bp + A, B); A = Ap + A; } while (0)
        MP_STEP(0x111, 0xF); MP_STEP(0x112, 0xF); MP_STEP(0x114, 0xF); MP_STEP(0x118, 0xF); MP_STEP(0x142, 0xA); MP_STEP(0x143, 0xC);
#undef MP_STEP
        const float mn = fmaxf(A, B);
        sm[tid + 1] = mn; if (tid == 0) sm[0] = 0.f;
        asm volatile("s_waitcnt lgkmcnt(0)" ::: "memory");
        const float mj = sm[tid];
        if (tid < 63) { sf[tid] = fexp(bl + mj - mn); sg[tid] = fexp(ml - mn); if (part == 0) WT_STF(MST + bh * 64 + tid + 1, mn); }
    }
    if (part == 0 && tid == 0) WT_STF(MST + bh * 64, 0.f);
    LDS_BAR_();
    unsigned* base = (unsigned*)(F.ws + WS_CST) + (size_t)bh * 64 * 8192 + part * 512 + tid;
    float* DN = (float*)(F.ws + WS_DN) + (size_t)bh * 64 * 128;
    float c0 = 0.f, c1 = 0.f, nn = 0.f;
    const bool nown = (part == 0 && tid < 128);
#ifdef SCAN_PIPE
#define SC_LOAD(d, dn, j0) do { _Pragma("unroll") for (int k = 0; k < 21; ++k) { d[k] = base[(size_t)((j0) + k) * 8192]; dn[k] = nown ? DN[((j0) + k) * 128 + tid] : 0.f; } } while (0)
#define SC_FOLD(d, dn, j0) do { _Pragma("unroll") for (int k = 0; k < 21; ++k) { const int j = (j0) + k; const float f = sf[j], g = sg[j]; \
            c0 = f * c0 + g * bflo(d[k]); c1 = f * c1 + g * bfhi(d[k]); base[(size_t)j * 8192] = cvtpk(c0, c1); \
            if (nown) { nn = f * nn + g * dn[k]; DN[j * 128 + tid] = nn; } } } while (0)
    { unsigned dA[21], dB[21]; float nA[21], nB[21];
#if SCAN_PIPE == 2
      unsigned dC[21]; float nC[21];
      SC_LOAD(dA, nA, 0); SC_LOAD(dB, nB, 21); SC_LOAD(dC, nC, 42);
      SC_FOLD(dA, nA, 0); SC_FOLD(dB, nB, 21); SC_FOLD(dC, nC, 42); }
#else
      SC_LOAD(dA, nA, 0); SC_LOAD(dB, nB, 21);
      SC_FOLD(dA, nA, 0);
      SC_LOAD(dA, nA, 42);
      SC_FOLD(dB, nB, 21);
      SC_FOLD(dA, nA, 42); }
#endif
#undef SC_LOAD
#undef SC_FOLD
#else
    for (int j0 = 0; j0 < 63; j0 += SC_B) {
        unsigned d[SC_B]; float dn[SC_B];
#pragma unroll
        for (int k = 0; k < SC_B; ++k) { d[k] = base[(size_t)(j0 + k) * 8192]; dn[k] = nown ? DN[(j0 + k) * 128 + tid] : 0.f; }
#pragma unroll
        for (int k = 0; k < SC_B; ++k) { const int j = j0 + k; const float f = sf[j], g = sg[j];
            c0 = f * c0 + g * bflo(d[k]); c1 = f * c1 + g * bfhi(d[k]);
            WT_ST32(base + (size_t)j * 8192, cvtpk(c0, c1));
            if (nown) { nn = f * nn + g * dn[k]; WT_STF(DN + j * 128 + tid, nn); }
        }
    }
#endif
#ifdef HO_M123
    ho_publish(F, CW_F2 + 256 * l + F.vcu);
#endif
}

__device__ __forceinline__ void conv_load(const bf16_t* PROJ, long row0, bool first, int pcol, int cp, int rg, unsigned (&x)[11]) {
    const char* base = (const char*)(PROJ + (row0 - 3) * LDP + pcol);
    const unsigned off = (unsigned)((8 * rg) * LDP + 2 * cp) * 2u;
#pragma unroll
    for (int i = 0; i < 11; ++i) { x[i] = 0u; if (!(first && 8 * rg + i < 3)) x[i] = *(const unsigned*)(base + (size_t)(off + (unsigned)(i * LDP * 2))); }
}
__device__ __forceinline__ void conv_calc(const unsigned (&x)[11], const float (&wt)[4][2], float (&y)[8][2]) {
#pragma unroll
    for (int r = 0; r < 8; ++r) {
        float a0 = wt[0][0] * bflo(x[r]), a1 = wt[0][1] * bfhi(x[r]);
#pragma unroll
        for (int k = 1; k < 4; ++k) { a0 += wt[k][0] * bflo(x[r + k]); a1 += wt[k][1] * bfhi(x[r + k]); }
        y[r][0] = silu(a0); y[r][1] = silu(a1); }
}
struct M3Pre { u32x4 v[2]; float ig, fg, mj, nst; };
__device__ __forceinline__ void m3_load(Frame& F, int item, int tid, M3Pre& P, unsigned raw_lds) {
    const int lane = tid & 63, wave = F.wave;
    const int bh = item >> 6, ch = item & 63, b = bh >> 2, h = bh & 3; const long row0 = (long)b * SEQ + ch * 64;
    const bf16_t* PROJ = (const bf16_t*)(F.ws + WS_PROJ);
    { const bf16_t* rb = PROJ + (row0 - 3) * LDP + h * 128;
      const unsigned lo = (unsigned)((lane >> 4) * LDP + (lane & 15) * 8) * 2u;
      for (int pc = wave; pc < 34; pc += NWAVES) { const int tsr = pc >= 17 ? 1 : 0, pp = pc - 17 * tsr;
          glds16s(rb, lo + (unsigned)((4 * pp) * LDP + (tsr ? P_KB : P_QB)) * 2u, (unsigned)__builtin_amdgcn_readfirstlane(raw_lds + tsr * 17408 + pp * 1024)); } }
#pragma unroll
    for (int ps = 0; ps < 2; ++ps) { const int row = (tid >> 4) + 32 * ps, chk = tid & 15; P.v[ps] = *(const u32x4*)(PROJ + (row0 + row) * LDP + P_VB + h * 128 + chk * 8); }
    P.ig = 0.f; P.fg = 0.f; P.mj = 0.f; P.nst = 0.f;
    if (wave == 0) { const float* GATES = (const float*)(F.ws + WS_GATES); P.ig = GATES[(row0 + lane) * 8 + h]; P.fg = GATES[(row0 + lane) * 8 + 4 + h]; P.mj = ((const float*)(F.ws + WS_MSC) + 2048)[item]; }
    else if (wave <= 2) { if (ch > 0) P.nst = ((const float*)(F.ws + WS_DN))[(size_t)(item - 1) * 128 + (tid - 64)]; }
}
__device__ __forceinline__ void m3_load_c(Frame& F, int item, int lane, unsigned ct_lds) {
    if ((item & 63) == 0) return;
    const bf16_t* CS = (const bf16_t*)(F.ws + WS_CST) + (size_t)(item - 1) * 16384;
#pragma unroll
    for (int j = 0; j < 4; ++j) { const int pc = F.wave * 4 + j, eb = pc >> 3, rgp = pc & 7;
        glds16s(CS, (unsigned)((16 * rgp + (lane >> 2)) * 128 + 32 * eb + (lane & 3) * 8) * 2u, (unsigned)__builtin_amdgcn_readfirstlane(ct_lds + eb * 8192 + rgp * 1024)); }
}
__device__ __forceinline__ void conv_lds(LAS const unsigned char* raw, bool first, int cp, int rg, LAS const float* cw, float (&y)[8][2]) {
    float wt[4][2];
#pragma unroll
    for (int k = 0; k < 4; ++k) { const f32x2 t = *(LAS const f32x2*)(cw + k * 128 + 2 * cp); wt[k][0] = t[0]; wt[k][1] = t[1]; }
    unsigned x[11];
#pragma unroll
    for (int i = 0; i < 11; ++i) { x[i] = *(LAS const unsigned*)(raw + (8 * rg + i) * 256 + cp * 4); if (first && 8 * rg + i < 3) x[i] = 0u; }
    conv_calc(x, wt, y);
}
__device__ __forceinline__ void mlstm3_run(Frame& F, int l, int item0) {
    int tid0 = F.tid; asm volatile("" : "+v"(tid0));
    const int wave = F.wave;
    const int h = (item0 >> 6) & 3;
    bf16_t* PROJ = (bf16_t*)(F.ws + WS_PROJ);
    LAS unsigned char* QT = F.lds; LAS unsigned char* KT = F.lds + 16384; LAS unsigned char* VT = F.lds + 32768; LAS unsigned char* CT = F.lds + 49152;
    LAS float* ST = (LAS float*)(F.lds);
    constexpr int RAW0 = 81920;
    LAS float* SC = (LAS float*)(F.lds + 139264);
    LAS float* gs = SC; LAS float* mx = SC + 64; LAS float* wint = SC + 128; LAS float* dfl = SC + 192; LAS float* qn = SC + 256; LAS float* nst = SC + 320;
    LAS float* nbL = SC + 448; LAS float* cwL = SC + 576;
    LAS float* wsf = (LAS float*)(F.lds + WSF_OFF) + wave * 64;
    const unsigned lds0 = (unsigned)(uintptr_t)F.lds;
    { const int tid = tid0;
    if (tid < 128) nbL[tid] = ARGP(8)[l * 512 + h * 128 + tid];
    { const float* cw = ARGP(5) + (size_t)l * 4096 + h * 128;
      for (int i = tid; i < 1024; i += NTHREADS) { const int qk = i >> 9, k = (i >> 7) & 3, d = i & 127; cwL[i] = cw[k * 1024 + qk * 512 + d]; } } }
    const float bi = ARGP(4)[l * 8 + h], bf_ = ARGP(4)[l * 8 + 4 + h];
    M3Pre P;
    m3_load(F, item0, tid0, P, lds0 + RAW0);
    m3_load_c(F, item0, tid0 & 63, lds0 + 49152);
    WG_BAR();
#pragma unroll 1
    for (int it = 0; it < 4; ++it) {
        const int item = item0 + it, ch = item & 63; const long row0 = (long)(item >> 8) * SEQ + ch * 64;
        int tid = tid0; asm volatile("" : "+v"(tid));
        int lane = tid & 63, cp = tid & 63, rg = tid >> 6;
        TSK(40);
        if (wave == 0) {
            const float bs = wave_prefix_sum(logsig(P.fg + bf_), lane);
            const float g = P.ig + bi - bs, pm = wave_prefix_max(g, lane), mxv = fmaxf(P.mj, pm);
            gs[lane] = g * LOG2E; mx[lane] = mxv * LOG2E; wint[lane] = fexp(P.mj - mxv); dfl[lane] = fexp(-(bs + mxv));
        } else if (wave <= 2) nst[tid - 64] = P.nst;
        { float y[8][2];
          conv_lds(F.lds + RAW0, ch == 0, cp, rg, cwL, y);
#pragma unroll
          for (int r = 0; r < 8; ++r) { const int s = 8 * rg + r, d = 2 * cp; *(LAS unsigned*)(QT + s * 256 + ((((d >> 3) ^ (s & 15))) << 4) + (d & 7) * 2) = cvtpk(y[r][0], y[r][1]); }
          conv_lds(F.lds + RAW0 + 17408, ch == 0, cp, rg, cwL + 512, y);
#pragma unroll
          for (int r = 0; r < 8; ++r) { const int s = 8 * rg + r, d = 2 * cp; *(LAS unsigned*)(KT + s * 256 + ((((d >> 3) ^ (s & 15))) << 4) + (d & 7) * 2) = cvtpk(y[r][0], y[r][1]); } }
#pragma unroll
        for (int ps = 0; ps < 2; ++ps) { const int row = (tid >> 4) + 32 * ps, chk = tid & 15;
            *(LAS u32x4*)(VT + (chk >> 2) * 4096 + (row >> 4) * 1024 + (row & 15) * 64 + (chk & 3) * 16) = P.v[ps]; }
        TSK(41);
        LDS_BAR();
        TSK(42);
        asm volatile("" : "+v"(tid)); lane = tid & 63;
        const int hi = lane >> 5, r32 = lane & 31;
        if (it + 1 < 4) m3_load(F, item + 1, tid, P, lds0 + RAW0);
        bf16_t* pr = PROJ + (row0 + (tid >> 3)) * LDP + h * 128 + (tid & 7) * 16;
        const u32x4 ob0 = *(const u32x4*)(pr + P_OB), ob1 = *(const u32x4*)(pr + P_OB + 8), zb0 = *(const u32x4*)(pr + P_ZB), zb1 = *(const u32x4*)(pr + P_ZB + 8);
        TSK(50);
        { const int t = tid >> 3, part = tid & 7; float a = 0.f;
#pragma unroll
          for (int k = 0; k < 2; ++k) { const int chk = 2 * part + k; const u32x4 w = *(LAS const u32x4*)(QT + t * 256 + ((chk ^ (t & 15)) << 4)); const LAS float* np = nst + chk * 8;
              a += bflo(w.x) * np[0] + bfhi(w.x) * np[1] + bflo(w.y) * np[2] + bfhi(w.y) * np[3] + bflo(w.z) * np[4] + bfhi(w.z) * np[5] + bflo(w.w) * np[6] + bfhi(w.w) * np[7]; }
          a += bperm(a, lane ^ 1); a += bperm(a, lane ^ 2); a += bperm(a, lane ^ 4);
          if (part == 0) qn[t] = a; }
        TSK(51);
        const int tb = wave & 1, eb = wave >> 1;
        const int tq = 32 * tb + r32;
        f32x16 p0, p1;
#pragma unroll
        for (int r = 0; r < 16; ++r) { p0[r] = 0.f; p1[r] = 0.f; }
#pragma unroll
        for (int hb = 0; hb < 2; ++hb) {
            bf16x8 qf[4], k0f[4], k1f[4];
#pragma unroll
            for (int j = 0; j < 4; ++j) { const int chk = 2 * (4 * hb + j) + hi;
                qf[j] = *(LAS const bf16x8*)(QT + tq * 256 + ((chk ^ (tq & 15)) << 4));
                k0f[j] = *(LAS const bf16x8*)(KT + r32 * 256 + ((chk ^ (r32 & 15)) << 4));
                k1f[j] = *(LAS const bf16x8*)(KT + (32 + r32) * 256 + ((chk ^ (r32 & 15)) << 4)); }
            SBAR();
#pragma unroll
            for (int j = 0; j < 4; ++j) { p0 = __builtin_amdgcn_mfma_f32_32x32x16_bf16(k0f[j], qf[j], p0, 0, 0, 0); p1 = __builtin_amdgcn_mfma_f32_32x32x16_bf16(k1f[j], qf[j], p1, 0, 0, 0); }
            SBAR();
        }
        TSK(52);
        const float mxt = mx[tq];
        float dsum = 0.f;
#pragma unroll
        for (int g = 0; g < 4; ++g) { const f32x4 g0 = *(LAS const f32x4*)(gs + 8 * g + 4 * hi), g1 = *(LAS const f32x4*)(gs + 32 + 8 * g + 4 * hi);
#pragma unroll
            for (int j = 0; j < 4; ++j) { const int r = 4 * g + j, s0 = 8 * g + 4 * hi + j;
                const float w0 = (s0 <= tq) ? ex2(g0[j] - mxt) * KSCALE : 0.f; p0[r] *= w0;
                const float w1 = (s0 + 32 <= tq) ? ex2(g1[j] - mxt) * KSCALE : 0.f; p1[r] *= w1;
                dsum += p0[r] + p1[r]; } }
        dsum = half_swap_add(dsum);
        u32x4 pw[4];
        pw[0] = (u32x4){cvtpk(p0[0], p0[1]), cvtpk(p0[2], p0[3]), cvtpk(p0[4], p0[5]), cvtpk(p0[6], p0[7])};
        pw[1] = (u32x4){cvtpk(p0[8], p0[9]), cvtpk(p0[10], p0[11]), cvtpk(p0[12], p0[13]), cvtpk(p0[14], p0[15])};
        pw[2] = (u32x4){cvtpk(p1[0], p1[1]), cvtpk(p1[2], p1[3]), cvtpk(p1[4], p1[5]), cvtpk(p1[6], p1[7])};
        pw[3] = (u32x4){cvtpk(p1[8], p1[9]), cvtpk(p1[10], p1[11]), cvtpk(p1[12], p1[13]), cvtpk(p1[14], p1[15])};
        TSK(53);
        const int trb = ((lane >> 4) & 1) * 32 + (lane & 3) * 8 + (4 * hi + ((lane & 15) >> 2)) * 64;
        f32x16 a1, a2;
#pragma unroll
        for (int r = 0; r < 16; ++r) { a1[r] = 0.f; a2[r] = 0.f; }
        { bf16x8 vf[4];
#pragma unroll
          for (int ks = 0; ks < 4; ++ks) vf[ks] = tr2(VT + eb * 4096 + ks * 1024 + trb);
          SBAR();
#pragma unroll
          for (int ks = 0; ks < 4; ++ks) a1 = __builtin_amdgcn_mfma_f32_32x32x16_bf16(__builtin_bit_cast(bf16x8, pw[ks]), vf[ks], a1, 0, 0, 0);
          SBAR(); }
        if (ch > 0) {
#pragma unroll
            for (int hb = 0; hb < 2; ++hb) {
                u32x4 qq[4]; bf16x8 cf[4];
#pragma unroll
                for (int j = 0; j < 4; ++j) { const int d0 = 4 * hb + j;
                    const u32x2 qa = *(LAS const u32x2*)(QT + tq * 256 + ((((2 * d0) ^ (tq & 15))) << 4) + 8 * hi), qb = *(LAS const u32x2*)(QT + tq * 256 + ((((2 * d0 + 1) ^ (tq & 15))) << 4) + 8 * hi);
                    qq[j] = (u32x4){qa.x, qa.y, qb.x, qb.y};
                    cf[j] = tr2(CT + eb * 8192 + d0 * 1024 + trb); }
                SBAR();
#pragma unroll
                for (int j = 0; j < 4; ++j) a2 = __builtin_amdgcn_mfma_f32_32x32x16_bf16(__builtin_bit_cast(bf16x8, qq[j]), cf[j], a2, 0, 0, 0);
                SBAR();
            }
        }
        TSK(43);
        LDS_BAR();
        if (it + 1 < 4) m3_load_c(F, item + 1, lane, lds0 + 49152);
        { const float den = dsum + wint[tq] * qn[tq]; const float hd = rcp(fmaxf(fabsf(den), dfl[tq]));
          if (hi == 0) wsf[r32] = hd; }
        asm volatile("s_waitcnt lgkmcnt(0)" ::: "memory");
#pragma unroll
        for (int g = 0; g < 4; ++g) { const f32x4 wi = *(LAS const f32x4*)(wint + 32 * tb + 8 * g + 4 * hi), hd4 = *(LAS const f32x4*)(wsf + 8 * g + 4 * hi);
#pragma unroll
            for (int j = 0; j < 4; ++j) { const int r = 4 * g + j, t = 32 * tb + 8 * g + 4 * hi + j;
                ST[t * 128 + 32 * eb + r32] = (a1[r] + wi[j] * a2[r]) * hd4[j]; } }
        LDS_BAR();
        TSK(44);
        { const int t = tid >> 3, part = tid & 7;
          float hv[16];
#pragma unroll
          for (int k = 0; k < 4; ++k) { const f32x4 v = *(LAS const f32x4*)(ST + t * 128 + part * 16 + 4 * k); hv[4 * k] = v[0]; hv[4 * k + 1] = v[1]; hv[4 * k + 2] = v[2]; hv[4 * k + 3] = v[3]; }
          const unsigned obw[8] = {ob0.x, ob0.y, ob0.z, ob0.w, ob1.x, ob1.y, ob1.z, ob1.w}, zbw[8] = {zb0.x, zb0.y, zb0.z, zb0.w, zb1.x, zb1.y, zb1.z, zb1.w};
          float ss = 0.f;
#pragma unroll
          for (int k = 0; k < 8; ++k) { hv[2 * k] *= sigm(bflo(obw[k])); hv[2 * k + 1] *= sigm(bfhi(obw[k])); ss += hv[2 * k] * hv[2 * k] + hv[2 * k + 1] * hv[2 * k + 1]; }
          ss += bperm(ss, lane ^ 1); ss += bperm(ss, lane ^ 2); ss += bperm(ss, lane ^ 4);
          const float rs = rsqrtf(ss * (1.f / 128.f) + EPS);
          unsigned ow[8];
#pragma unroll
          for (int k = 0; k < 8; ++k) { const f32x2 nb2 = *(LAS const f32x2*)(nbL + part * 16 + 2 * k);
              ow[k] = cvtpk(hv[2 * k] * rs * nb2[0] * silu(bflo(zbw[k])), hv[2 * k + 1] * rs * nb2[1] * silu(bfhi(zbw[k]))); }
          asm volatile("s_waitcnt vmcnt(0)" ::: "memory");

#ifdef HO_AMG
          st16_wt(F.ws, (size_t)((unsigned char*)(pr + P_YB) - F.ws), (u32x4){ow[0], ow[1], ow[2], ow[3]}); st16_wt(F.ws, (size_t)((unsigned char*)(pr + P_YB + 8) - F.ws), (u32x4){ow[4], ow[5], ow[6], ow[7]}); }
#else
          *(u32x4*)(pr + P_YB) = (u32x4){ow[0], ow[1], ow[2], ow[3]}; *(u32x4*)(pr + P_YB + 8) = (u32x4){ow[4], ow[5], ow[6], ow[7]}; }
#endif

        TSK(45);
        LDS_BAR();
    }
    asm volatile("s_waitcnt vmcnt(0)" ::: "memory");
}

struct M3PreD { u32x4 v[2]; float ig, fg, mj, nst, cw0, cw1, nb; };
__device__ __forceinline__ void m3_load_d(Frame& F, int l, int item, int tid, M3PreD& P, unsigned raw_lds) {
    const int lane = tid & 63, wave = F.wave;
    const int bh = item >> 6, ch = item & 63, b = bh >> 2, h = bh & 3; const long row0 = (long)b * SEQ + ch * 64;
    const bf16_t* PROJ = (const bf16_t*)(F.ws + WS_PROJ);
    { const bf16_t* rb = PROJ + (row0 - 3) * LDP + h * 128;
      const unsigned lo = (unsigned)((lane >> 4) * LDP + (lane & 15) * 8) * 2u;
      for (int pc = wave; pc < 34; pc += NWAVES) { const int tsr = pc >= 17 ? 1 : 0, pp = pc - 17 * tsr;
          glds16s(rb, lo + (unsigned)((4 * pp) * LDP + (tsr ? P_KB : P_QB)) * 2u, (unsigned)__builtin_amdgcn_readfirstlane(raw_lds + tsr * 17408 + pp * 1024)); } }
#pragma unroll
    for (int ps = 0; ps < 2; ++ps) { const int row = (tid >> 4) + 32 * ps, chk = tid & 15; P.v[ps] = *(const u32x4*)(PROJ + (row0 + row) * LDP + P_VB + h * 128 + chk * 8); }
    P.ig = 0.f; P.fg = 0.f; P.mj = 0.f; P.nst = 0.f;
    if (wave == 0) { const float* GATES = (const float*)(F.ws + WS_GATES); const float* gb = ARGP(4) + l * 8 + h;
        P.ig = GATES[(row0 + lane) * 8 + h] + gb[0]; P.fg = GATES[(row0 + lane) * 8 + 4 + h] + gb[4]; P.mj = ((const float*)(F.ws + WS_MSC) + 2048)[item]; }
    else if (wave <= 2) { if (ch > 0) P.nst = ((const float*)(F.ws + WS_DN))[(size_t)(item - 1) * 128 + (tid - 64)]; }
    { const float* cw = ARGP(5) + (size_t)l * 4096 + h * 128; const int k = (tid >> 7) & 3, dd = tid & 127; P.cw0 = cw[k * 1024 + dd]; P.cw1 = cw[k * 1024 + 512 + dd]; }
    P.nb = 0.f; if (tid < 128) P.nb = ARGP(8)[l * 512 + h * 128 + tid];
}
__device__ __forceinline__ void mlstm3_dyn(Frame& F, int l) {
    int tid0 = F.tid; asm volatile("" : "+v"(tid0));
    const int wave = F.wave;
    bf16_t* PROJ = (bf16_t*)(F.ws + WS_PROJ);
    LAS unsigned char* QT = F.lds; LAS unsigned char* KT = F.lds + 16384; LAS unsigned char* VT = F.lds + 32768; LAS unsigned char* CT = F.lds + 49152;
    LAS float* ST = (LAS float*)(F.lds);
    constexpr int RAW0 = 81920;
    LAS float* SC = (LAS float*)(F.lds + 139264);
    LAS float* gs = SC; LAS float* mx = SC + 64; LAS float* wint = SC + 128; LAS float* dfl = SC + 192; LAS float* qn = SC + 256; LAS float* nst = SC + 320;
    LAS float* nbL0 = SC + 448; LAS float* cwL = SC + 576;
    LAS float* wsf = (LAS float*)(F.lds + WSF_OFF) + wave * 64;
    const unsigned lds0 = (unsigned)(uintptr_t)F.lds;
    volatile LAS unsigned* MISCq = (volatile LAS unsigned*)(F.lds + MISC_OFF);
    unsigned* Q = (unsigned*)(F.ws + WS_CTL) + CW_M3Q + 32 * l;
#ifdef M3_STATIC2
    int cur = F.vcu, nxt = F.G + F.vcu;
    const unsigned qbase = 2u * (unsigned)F.G;
#else
    const unsigned qbase = 0u;
#ifdef HO_M123
    unsigned c0_ = 0u, c1_ = 0u; if (is_t0(wave)) { c0_ = xb_add(Q, 1u); c1_ = xb_add(Q, 1u); }
#ifdef HO_M3HIDE
    if (MISCq[27] == 0u)
#endif
    ho_wait<256>(F, CW_F2 + 256 * l);
    if (is_t0(wave)) { MISCq[24] = c0_; MISCq[25] = c1_; }
    __syncthreads();
#else
    if (is_t0(wave)) { const unsigned c0 = xb_add(Q, 1u), c1 = xb_add(Q, 1u); MISCq[24] = c0; MISCq[25] = c1; }
    __syncthreads();
#endif
    int cur = __builtin_amdgcn_readfirstlane((int)MISCq[24]), nxt = __builtin_amdgcn_readfirstlane((int)MISCq[25]);
    if (cur >= 1024) return;
#endif
    M3PreD P;
    m3_load_d(F, l, cur, tid0, P, lds0 + RAW0);
    m3_load_c(F, cur, tid0 & 63, lds0 + 49152);
    cwL[tid0] = P.cw0; cwL[tid0 + 512] = P.cw1; if (tid0 < 128) nbL0[tid0] = P.nb;
    WG_BAR();
    int par = 0;
#pragma unroll 1
    for (;;) {
        const int item = cur, ch = item & 63, h = (item >> 6) & 3; const long row0 = (long)(item >> 8) * SEQ + ch * 64;
        LAS float* nbL = nbL0 + par * 1152;
        int tid = tid0; asm volatile("" : "+v"(tid));
        int lane = tid & 63, cp = tid & 63, rg = tid >> 6;
        TSK(40);
        if (wave == 0) {
            const float bs = wave_prefix_sum(logsig(P.fg), lane);
            const float g = P.ig - bs, pm = wave_prefix_max(g, lane), mxv = fmaxf(P.mj, pm);
            gs[lane] = g * LOG2E; mx[lane] = mxv * LOG2E; wint[lane] = fexp(P.mj - mxv); dfl[lane] = fexp(-(bs + mxv));
        } else if (wave <= 2) nst[tid - 64] = P.nst;
        { float y[8][2];
          conv_lds(F.lds + RAW0, ch == 0, cp, rg, cwL, y);
#pragma unroll
          for (int r = 0; r < 8; ++r) { const int s = 8 * rg + r, d = 2 * cp; *(LAS unsigned*)(QT + s * 256 + ((((d >> 3) ^ (s & 15))) << 4) + (d & 7) * 2) = cvtpk(y[r][0], y[r][1]); }
          conv_lds(F.lds + RAW0 + 17408, ch == 0, cp, rg, cwL + 512, y);
#pragma unroll
          for (int r = 0; r < 8; ++r) { const int s = 8 * rg + r, d = 2 * cp; *(LAS unsigned*)(KT + s * 256 + ((((d >> 3) ^ (s & 15))) << 4) + (d & 7) * 2) = cvtpk(y[r][0], y[r][1]); } }
#pragma unroll
        for (int ps = 0; ps < 2; ++ps) { const int row = (tid >> 4) + 32 * ps, chk = tid & 15;
            *(LAS u32x4*)(VT + (chk >> 2) * 4096 + (row >> 4) * 1024 + (row & 15) * 64 + (chk & 3) * 16) = P.v[ps]; }
        TSK(41);
        LDS_BAR();
        TSK(42);
        asm volatile("" : "+v"(tid)); lane = tid & 63;
        const int hi = lane >> 5, r32 = lane & 31;
        if (nxt < 1024) m3_load_d(F, l, nxt, tid, P, lds0 + RAW0);
        unsigned claim = 0u; if (is_t0(wave)) claim = xb_add(Q, 1u) + qbase;
        bf16_t* pr = PROJ + (row0 + (tid >> 3)) * LDP + h * 128 + (tid & 7) * 16;
        const u32x4 ob0 = *(const u32x4*)(pr + P_OB), ob1 = *(const u32x4*)(pr + P_OB + 8), zb0 = *(const u32x4*)(pr + P_ZB), zb1 = *(const u32x4*)(pr + P_ZB + 8);
        TSK(50);
        { const int t = tid >> 3, part = tid & 7; float a = 0.f;
#pragma unroll
          for (int k = 0; k < 2; ++k) { const int chk = 2 * part + k; const u32x4 w = *(LAS const u32x4*)(QT + t * 256 + ((chk ^ (t & 15)) << 4)); const LAS float* np = nst + chk * 8;
              a += bflo(w.x) * np[0] + bfhi(w.x) * np[1] + bflo(w.y) * np[2] + bfhi(w.y) * np[3] + bflo(w.z) * np[4] + bfhi(w.z) * np[5] + bflo(w.w) * np[6] + bfhi(w.w) * np[7]; }
          a += bperm(a, lane ^ 1); a += bperm(a, lane ^ 2); a += bperm(a, lane ^ 4);
          if (part == 0) qn[t] = a; }
        TSK(51);
        const int tb = wave & 1, eb = wave >> 1;
        const int tq = 32 * tb + r32;
        f32x16 p0, p1;
#pragma unroll
        for (int r = 0; r < 16; ++r) { p0[r] = 0.f; p1[r] = 0.f; }
#pragma unroll
        for (int hb = 0; hb < 2; ++hb) {
            bf16x8 qf[4], k0f[4], k1f[4];
#pragma unroll
            for (int j = 0; j < 4; ++j) { const int chk = 2 * (4 * hb + j) + hi;
                qf[j] = *(LAS const bf16x8*)(QT + tq * 256 + ((chk ^ (tq & 15)) << 4));
                k0f[j] = *(LAS const bf16x8*)(KT + r32 * 256 + ((chk ^ (r32 & 15)) << 4));
                k1f[j] = *(LAS const bf16x8*)(KT + (32 + r32) * 256 + ((chk ^ (r32 & 15)) << 4)); }
            SBAR();
#pragma unroll
            for (int j = 0; j < 4; ++j) { p0 = __builtin_amdgcn_mfma_f32_32x32x16_bf16(k0f[j], qf[j], p0, 0, 0, 0); p1 = __builtin_amdgcn_mfma_f32_32x32x16_bf16(k1f[j], qf[j], p1, 0, 0, 0); }
            SBAR();
        }
        TSK(52);
        const float mxt = mx[tq];
        float dsum = 0.f;
#pragma unroll
        for (int g = 0; g < 4; ++g) { const f32x4 g0 = *(LAS const f32x4*)(gs + 8 * g + 4 * hi), g1 = *(LAS const f32x4*)(gs + 32 + 8 * g + 4 * hi);
#pragma unroll
            for (int j = 0; j < 4; ++j) { const int r = 4 * g + j, s0 = 8 * g + 4 * hi + j;
                const float w0 = (s0 <= tq) ? ex2(g0[j] - mxt) * KSCALE : 0.f; p0[r] *= w0;
                const float w1 = (s0 + 32 <= tq) ? ex2(g1[j] - mxt) * KSCALE : 0.f; p1[r] *= w1;
                dsum += p0[r] + p1[r]; } }
        dsum = half_swap_add(dsum);
        u32x4 pw[4];
        pw[0] = (u32x4){cvtpk(p0[0], p0[1]), cvtpk(p0[2], p0[3]), cvtpk(p0[4], p0[5]), cvtpk(p0[6], p0[7])};
        pw[1] = (u32x4){cvtpk(p0[8], p0[9]), cvtpk(p0[10], p0[11]), cvtpk(p0[12], p0[13]), cvtpk(p0[14], p0[15])};
        pw[2] = (u32x4){cvtpk(p1[0], p1[1]), cvtpk(p1[2], p1[3]), cvtpk(p1[4], p1[5]), cvtpk(p1[6], p1[7])};
        pw[3] = (u32x4){cvtpk(p1[8], p1[9]), cvtpk(p1[10], p1[11]), cvtpk(p1[12], p1[13]), cvtpk(p1[14], p1[15])};
        TSK(53);
        const int trb = ((lane >> 4) & 1) * 32 + (lane & 3) * 8 + (4 * hi + ((lane & 15) >> 2)) * 64;
        f32x16 a1, a2;
#pragma unroll
        for (int r = 0; r < 16; ++r) { a1[r] = 0.f; a2[r] = 0.f; }
        { bf16x8 vf[4];
#pragma unroll
          for (int ks = 0; ks < 4; ++ks) vf[ks] = tr2(VT + eb * 4096 + ks * 1024 + trb);
          SBAR();
#pragma unroll
          for (int ks = 0; ks < 4; ++ks) a1 = __builtin_amdgcn_mfma_f32_32x32x16_bf16(__builtin_bit_cast(bf16x8, pw[ks]), vf[ks], a1, 0, 0, 0);
          SBAR(); }
        if (ch > 0) {
#pragma unroll
            for (int hb = 0; hb < 2; ++hb) {
                u32x4 qq[4]; bf16x8 cf[4];
#pragma unroll
                for (int j = 0; j < 4; ++j) { const int d0 = 4 * hb + j;
                    const u32x2 qa = *(LAS const u32x2*)(QT + tq * 256 + ((((2 * d0) ^ (tq & 15))) << 4) + 8 * hi), qb = *(LAS const u32x2*)(QT + tq * 256 + ((((2 * d0 + 1) ^ (tq & 15))) << 4) + 8 * hi);
                    qq[j] = (u32x4){qa.x, qa.y, qb.x, qb.y};
                    cf[j] = tr2(CT + eb * 8192 + d0 * 1024 + trb); }
                SBAR();
#pragma unroll
                for (int j = 0; j < 4; ++j) a2 = __builtin_amdgcn_mfma_f32_32x32x16_bf16(__builtin_bit_cast(bf16x8, qq[j]), cf[j], a2, 0, 0, 0);
                SBAR();
            }
        }
        TSK(43);
        LDS_BAR();
        if (nxt < 1024) m3_load_c(F, nxt, lane, lds0 + 49152);
        { const float den = dsum + wint[tq] * qn[tq]; const float hd = rcp(fmaxf(fabsf(den), dfl[tq]));
          if (hi == 0) wsf[r32] = hd; }
        asm volatile("s_waitcnt lgkmcnt(0)" ::: "memory");
#pragma unroll
        for (int g = 0; g < 4; ++g) { const f32x4 wi = *(LAS const f32x4*)(wint + 32 * tb + 8 * g + 4 * hi), hd4 = *(LAS const f32x4*)(wsf + 8 * g + 4 * hi);
#pragma unroll
            for (int j = 0; j < 4; ++j) { const int r = 4 * g + j, t = 32 * tb + 8 * g + 4 * hi + j;
                ST[t * 128 + 32 * eb + r32] = (a1[r] + wi[j] * a2[r]) * hd4[j]; } }
        LDS_BAR();
        TSK(44);
        { const int t = tid >> 3, part = tid & 7;
          float hv[16];
#pragma unroll
          for (int k = 0; k < 4; ++k) { const f32x4 v = *(LAS const f32x4*)(ST + t * 128 + part * 16 + 4 * k); hv[4 * k] = v[0]; hv[4 * k + 1] = v[1]; hv[4 * k + 2] = v[2]; hv[4 * k + 3] = v[3]; }
          const unsigned obw[8] = {ob0.x, ob0.y, ob0.z, ob0.w, ob1.x, ob1.y, ob1.z, ob1.w}, zbw[8] = {zb0.x, zb0.y, zb0.z, zb0.w, zb1.x, zb1.y, zb1.z, zb1.w};
          float ss = 0.f;
#pragma unroll
          for (int k = 0; k < 8; ++k) { hv[2 * k] *= sigm(bflo(obw[k])); hv[2 * k + 1] *= sigm(bfhi(obw[k])); ss += hv[2 * k] * hv[2 * k] + hv[2 * k + 1] * hv[2 * k + 1]; }
          ss += bperm(ss, lane ^ 1); ss += bperm(ss, lane ^ 2); ss += bperm(ss, lane ^ 4);
          const float rs = rsqrtf(ss * (1.f / 128.f) + EPS);
          unsigned ow[8];
#pragma unroll
          for (int k = 0; k < 8; ++k) { const f32x2 nb2 = *(LAS const f32x2*)(nbL + part * 16 + 2 * k);
              ow[k] = cvtpk(hv[2 * k] * rs * nb2[0] * silu(bflo(zbw[k])), hv[2 * k + 1] * rs * nb2[1] * silu(bfhi(zbw[k]))); }
          asm volatile("s_waitcnt vmcnt(0)" ::: "memory");

#ifdef HO_AMG
          st16_wt(F.ws, (size_t)((unsigned char*)(pr + P_YB) - F.ws), (u32x4){ow[0], ow[1], ow[2], ow[3]}); st16_wt(F.ws, (size_t)((unsigned char*)(pr + P_YB + 8) - F.ws), (u32x4){ow[4], ow[5], ow[6], ow[7]}); }
#else
          *(u32x4*)(pr + P_YB) = (u32x4){ow[0], ow[1], ow[2], ow[3]}; *(u32x4*)(pr + P_YB + 8) = (u32x4){ow[4], ow[5], ow[6], ow[7]}; }
#endif

        TSK(45);
        if (nxt < 1024) { cwL[tid] = P.cw0; cwL[tid + 512] = P.cw1; if (tid < 128) nbL0[(par ^ 1) * 1152 + tid] = P.nb; }
        if (is_t0(wave)) MISCq[24] = claim;
        LDS_BAR();
        cur = nxt; nxt = __builtin_amdgcn_readfirstlane((int)MISCq[24]); par ^= 1;
        if (cur >= 1024) break;
    }
    asm volatile("s_waitcnt vmcnt(0)" ::: "memory");
}
constexpr int NPHASES = 17;
#ifndef MK_NT_OUT
#define MK_NT_OUT 0
#endif
#ifndef MK_NT_PROJ
#define MK_NT_PROJ 0
#endif
#ifndef MK_TOFF
#define MK_TOFF 0
#endif
#ifndef MK_ONLY
#define MK_ONLY -1
#endif
#define EN(k) (MK_ONLY < 0 || MK_ONLY == (k))
struct Args { const float* in[12]; float* out; unsigned char* ws; int ph_lo, ph_hi; };

__global__ void __launch_bounds__(NTHREADS, 2) fwd_kernel(Args args) {
    extern __shared__ __attribute__((aligned(16))) unsigned char lds_raw[];
    Frame F;
    F.lds = (LAS unsigned char*)lds_raw;
    F.wave = __builtin_amdgcn_readfirstlane(threadIdx.x >> 6); F.tid = 0; F.lane = 0;
    F.G = gridDim.x; { const int bx = blockIdx.x; F.vcu = (F.G % 8 == 0) ? (bx % 8) * (F.G / 8) + bx / 8 : bx; }
    F.ws = args.ws;
    volatile LAS unsigned* MISC = (volatile LAS unsigned*)(F.lds + MISC_OFF);
    for (int u = threadIdx.x; u < (LDS_BYTES - LDSCTL_OFF) / 4; u += NTHREADS) ((LAS unsigned*)(F.lds + LDSCTL_OFF))[u] = 0u;
    __syncthreads();
#if MK_LAUNCH_MODE == 1
    constexpr int lo = 0, hi = NPHASES; constexpr bool use_bar = true;
#else
    const int lo = args.ph_lo, hi = args.ph_hi;
    const bool use_bar = (hi - lo) > 1;
#endif
    XcdBarrier bar; bar.bar = (unsigned*)(F.ws + WS_CTL) + CW_BAR; bar.x = 0; bar.st = nullptr; bar.wave = F.wave;
    if (use_bar) bar = xcd_barrier_post((unsigned*)(F.ws + WS_CTL) + CW_BAR, MISC + 8, F.wave);
#define RETID() do { int l_ = lane_now(); asm volatile("" : "+v"(l_)); F.lane = l_; F.tid = F.wave * 64 + l_; { int v_ = F.vcu, w_ = F.wave; GAS unsigned char* ws_ = (GAS unsigned char*)F.ws; asm volatile("" : "+s"(v_), "+s"(w_), "+s"(ws_)); F.vcu = v_; F.wave = w_; F.ws = (unsigned char*)ws_; } } while (0)
#define IN(k) (lo <= (k) && (k) < hi)
#ifdef MK_TPROBE
    if (is_t0(F.wave)) { const unsigned long long t0_ = __builtin_amdgcn_s_memrealtime(); MISC[16] = (unsigned)t0_; MISC[17] = (unsigned)(t0_ >> 32); MISC[18] = 0u; }
#define TSTAMP(kind_) do { if (is_t0(F.wave)) { const unsigned long long tn_ = __builtin_amdgcn_s_memrealtime(); const unsigned long long tp_ = ((unsigned long long)MISC[17] << 32) | MISC[16]; \
        if ((kind_) == MK_TPROBE || MK_TPROBE == 99) MISC[18] = __float_as_uint(__uint_as_float(MISC[18]) + (float)(tn_ - tp_) * 0.01f); MISC[16] = (unsigned)tn_; MISC[17] = (unsigned)(tn_ >> 32); } } while (0)
#define SEAM(k) do { if (IN((k) + 1)) xcd_barrier(bar); TSTAMP(((k) == 0) ? 0 : (((k) - 1) % 8) + 1); } while (0)
#else
#define SEAM(k) do { if (IN((k) + 1)) xcd_barrier(bar); } while (0)
#endif

#if defined(HO_P0) && defined(HO_M123) && MK_LAUNCH_MODE == 1
    if (EN(0) && IN(0)) { RETID(); p0_weights(F, 0, true); RETID(); norm_pass<0>(F, ARGP(0), nullptr, nullptr, ARGP(1), ARGP(3));
        ho_publish(F, 8192 + F.vcu);
#ifdef HO_NG2
        RETID(); p0_weights(F, 1, true); ho_publish(F, 8704 + F.vcu);
#else
        RETID(); p0_weights(F, 1, false);
#endif
        ho_wait<256>(F, 8192); }
#else
    if (EN(0) && IN(0)) { RETID(); p0_weights(F);
#ifdef MK_TPROBE
        __syncthreads(); TSTAMP(30);
#endif
        RETID(); norm_pass<0>(F, ARGP(0), nullptr, nullptr, ARGP(1), ARGP(3)); SEAM(0); }
#endif

    for (int l = 0; l < 2; ++l) {
        const int pb = 1 + 8 * l;
#define PROJ ((bf16_t*)(F.ws + WS_PROJ))
#define HN ((bf16_t*)(F.ws + WS_HN))
#define WIN ((const bf16_t*)(F.ws + WS_WIN) + (size_t)l * NL * D)
#define WAB ((const bf16_t*)(F.ws + WS_WAB) + (size_t)l * D * D)
#define WOUT ((const bf16_t*)(F.ws + WS_WOUT) + (size_t)l * D * D)
        if (EN(1) && IN(pb + 0)) { RETID();
            Gemm g{HN, WIN, M, NLA, D, D}; StaticOrder S; S.init(M, NLA, F.G, (int)blockIdx.x);
            Epi<0> E{PROJ, LDP, nullptr, nullptr}; E.nts = MK_NT_PROJ;
#ifdef G1A_WT
            E.wt = 1;
#endif
#ifdef MK_WIDE
            g.wide = 1; E.wide = 1;
#endif
#if defined(HO_NG2) && defined(HO_P0) && defined(HO_G3N) && MK_LAUNCH_MODE == 1 && !defined(MK_NO_HALFM) && !defined(MK_HALF_STAGGER)
            if (l == 1) { ho_wait<256, false>(F, 8704); Unit u0; if (S.next(0, u0)) ho_wait4(F, CW_NF + 4 * u0.pm); }
#endif
#if MK_LAUNCH_MODE == 1 && !defined(MK_NO_HALFM)
            S.max_i = 4;
#ifdef MK_HALF_STAGGER
            const int hfirst = ((int)blockIdx.x >> 3) & 1;
#pragma unroll 1
            for (int pass = 0; pass < 2; ++pass) {
                RETID();
                if ((pass == 0) == (hfirst != 0)) { HalfOrder H; H.init(M, NLA, F.G, (int)blockIdx.x, 4); Epi<0> EH{PROJ, LDP, nullptr, nullptr}; EH.half = 1; EH.nts = MK_NT_PROJ; EH.wide = E.wide; EH.wt = E.wt;
                    gemm_phase<Epi<0>, false, HalfOrder, true>(F.lds, g, H, EH, F.wave); }
                else gemm_phase<Epi<0>, true, StaticOrder>(F.lds, g, S, E, F.wave);
            }
#else
#if defined(HO_NG2) && defined(HO_P0) && defined(HO_G3N) && MK_LAUNCH_MODE == 1
            if (l == 1) { AllN hk{F.ws}; gemm_phase<Epi<0>, true, StaticOrder, false, AllN>(F.lds, g, S, E, F.wave, hk); }
            else
#endif
            gemm_phase<Epi<0>, true, StaticOrder>(F.lds, g, S, E, F.wave);
#if defined(HO_G1EARLY) && defined(HO_G1)
            ho_publish(F, (l == 0 ? 768 : 1664) + (int)blockIdx.x);
#endif
            { RETID(); HalfOrder H; H.init(M, NLA, F.G, (int)blockIdx.x, 4); Epi<0> EH{PROJ, LDP, nullptr, nullptr}; EH.half = 1; EH.nts = MK_NT_PROJ; EH.wide = E.wide; EH.wt = E.wt;
              gemm_phase<Epi<0>, false, HalfOrder, true>(F.lds, g, H, EH, F.wave); }
#endif
#else
            gemm_phase<Epi<0>, true, StaticOrder>(F.lds, g, S, E, F.wave);
#endif
#if defined(HO_G1) && MK_LAUNCH_MODE == 1 && !defined(MK_NO_HALFM)
            ho_publish(F, CW_G1 + 256 * l + (int)blockIdx.x);
#else
            SEAM(pb + 0);
#endif
        }
#ifdef MK_REORDER
#if defined(HO_M123) && MK_LAUNCH_MODE == 1
#ifdef HO_G1
        if (EN(2) && IN(pb + 1)) { RETID(); ho_wait_m1(F, l); RETID(); mlstm1_run(F, l, F.vcu * 4); }
#else
        if (EN(2) && IN(pb + 1)) { RETID(); mlstm1_run(F, l, F.vcu * 4); }
#endif
        if (EN(3) && IN(pb + 2)) { RETID(); mlstm_scan(F, l); }
#define HO_M123_ACTIVE
#endif
#ifndef HO_M123_ACTIVE
        if (EN(2) && IN(pb + 1)) { RETID(); mlstm1_run(F, l, F.vcu * 4); SEAM(pb + 1); }
#ifdef AT_PREFETCH
        if (EN(3) && IN(pb + 2)) { RETID(); { const int bh = F.vcu >> 4, s = F.vcu & 15; attn_prefetch(F, bh >> 2, bh & 3, 31 - s); } RETID(); mlstm_scan(F); SEAM(pb + 2); }
#else
        if (EN(3) && IN(pb + 2)) { RETID(); mlstm_scan(F); SEAM(pb + 2); }
#endif
#endif
        if (EN(4) && IN(pb + 3)) { RETID();
#ifdef MK_M3_FIRST
            mlstm3_run(F, l, F.vcu * 4); RETID();
#endif
#if defined(HO_G1) && MK_LAUNCH_MODE == 1
#ifdef HO_NOACQ
            if (((volatile LAS unsigned*)(F.lds + MISC_OFF))[26] == 0u) ho_wait<256, false>(F, CW_G1 + 256 * l);
#else
            if (((volatile LAS unsigned*)(F.lds + MISC_OFF))[26] == 0u) ho_wait<256>(F, CW_G1 + 256 * l);
#endif
            RETID();
#endif
            { const int bh = F.vcu >> 4, s = F.vcu & 15;
#ifdef AT_PREFETCH
              attn_unit<8, true>(F, l, bh >> 2, bh & 3, 31 - s); RETID(); attn_unit<8, false>(F, l, bh >> 2, bh & 3, s); }
#else
#if defined(HO_M3HIDE) && defined(HO_M123) && MK_LAUNCH_MODE == 1
              attn_unit<8>(F, l, bh >> 2, bh & 3, 31 - s);
              if (F.wave == 0) { const int ln = lane_now(); unsigned* ps = (unsigned*)(F.ws + WS_CTL) + CW_F2 + 256 * l; bool oks = true;
#pragma unroll
                  for (int k = 0; k < 4; ++k) oks = oks && (xb_ld(ps + ln + 64 * k) != 0u);
                  const bool alls = __all(oks);
                  if (ln == 0) { if (alls) __builtin_amdgcn_fence(__ATOMIC_ACQUIRE, "agent"); ((volatile LAS unsigned*)(F.lds + MISC_OFF))[27] = alls ? 1u : 0u; } }
              RETID(); attn_unit<8>(F, l, bh >> 2, bh & 3, s); }
#else
              for (int k = 0; k < 2; ++k) attn_unit<8>(F, l, bh >> 2, bh & 3, k == 0 ? 31 - s : s); }
#endif
#endif
#ifdef MK_TPROBE
            TSTAMP(20);
#endif
#ifndef MK_M3_FIRST
#ifdef MK_M3_DYN
            RETID(); mlstm3_dyn(F, l);
#else
            RETID(); mlstm3_run(F, l, F.vcu * 4);
#endif
#endif
#if defined(HO_AMG) && defined(HO_M123) && defined(MK_M3_DYN) && MK_LAUNCH_MODE == 1
            ho_publish(F, CW_AM + 256 * l + F.vcu);
            if (is_t0(F.wave)) __builtin_amdgcn_fence(__ATOMIC_ACQUIRE, "agent");
#define HO_AMG_ACTIVE
            }
#else
            SEAM(pb + 3); }
#endif
#else
        if (EN(2) && IN(pb + 1)) { RETID();
#ifndef MK_NO_ML1
            mlstm1_run(F, l, F.vcu * 4);
#endif
#ifdef MK_TPROBE
            TSTAMP(20);
#endif
#ifndef MK_NO_ATT
            const int bh = F.vcu >> 4, s = F.vcu & 15;
            for (int k = 0; k < 2; ++k) attn_unit<8>(F, l, bh >> 2, bh & 3, k == 0 ? 31 - s : s);
#endif
#ifdef MK_TPROBE
            TSTAMP(21);
#endif
            SEAM(pb + 1);
        }
        if (EN(3) && IN(pb + 2)) { RETID(); mlstm_scan(F); SEAM(pb + 2); }
        if (EN(4) && IN(pb + 3)) { RETID(); mlstm3_run(F, l, F.vcu * 4); SEAM(pb + 3); }
#endif
        if (EN(5) && IN(pb + 4)) { RETID();
            Gemm g{HN, WIN + (size_t)NLA * D, M, 2048, D, D}; PairedOrder S; S.init(M, D, F.G, (int)blockIdx.x);
            Epi<1> E{PROJ + P_SGA, LDP, nullptr, PROJ + P_SGB};
#ifdef HO_AMG_ACTIVE
            { AllAM hk{F.ws, CW_AM + 256 * l}; gemm_phase<Epi<1>, true, PairedOrder, false, AllAM>(F.lds, g, S, E, F.wave, hk); }
#else
            gemm_phase<Epi<1>, true, PairedOrder>(F.lds, g, S, E, F.wave);
#endif
#if MK_LAUNCH_MODE == 1
            asm volatile("s_waitcnt vmcnt(0)" ::: "memory"); __syncthreads();
#ifndef NO_HANDOVER_FENCE
            if (is_t0(F.wave)) { __builtin_amdgcn_fence(__ATOMIC_ACQUIRE, "agent"); asm volatile("s_waitcnt vmcnt(0)" ::: "memory"); }
#endif
            __syncthreads();
#ifdef MK_TPROBE
            TSTAMP(5);
#endif
#else
            SEAM(pb + 4);
#endif
        }
        if (EN(6) && IN(pb + 5)) { RETID();
            Gemm g{PROJ + P_YA, WAB, M, D, D, LDP}; StaticOrder S; S.init(M, D, F.G, (int)blockIdx.x); g.ajump = (P_YB - 512) * 2;
            Epi<2> E{PROJ + P_MG, LDP, PROJ + P_SGA, PROJ + P_SGB};
#if defined(HO_G23) && MK_LAUNCH_MODE == 1
            E.wt = 1;
            gemm_phase<Epi<2>, false, StaticOrder>(F.lds, g, S, E, F.wave);
            { Unit u0; if (S.next(0, u0) && is_t0(F.wave)) __hip_atomic_store((unsigned*)(F.ws + WS_CTL) + CW_PANEL2 + 256 * l + 4 * u0.pm + u0.pn, 1u, __ATOMIC_RELAXED, __HIP_MEMORY_SCOPE_AGENT); }
#else
            gemm_phase<Epi<2>, false, StaticOrder>(F.lds, g, S, E, F.wave);
            SEAM(pb + 5);
#endif
        }
        if (EN(7) && IN(pb + 6)) { RETID();
            Gemm g{PROJ + P_MG, WOUT, M, D, D, LDP}; StaticOrder S; S.init(M, D, F.G, (int)blockIdx.x);
            Epi<0> E{PROJ + P_OUT, LDP, nullptr, nullptr}; E.nts = MK_NT_OUT;
#ifdef MK_WIDE
            g.wide = 1; E.wide = 1;
#endif
#if defined(HO_G23) && MK_LAUNCH_MODE == 1
            { Unit u0; if (S.next(0, u0)) { if (F.wave == 0) { const int ln = lane_now();
                  unsigned* pf = (unsigned*)(F.ws + WS_CTL) + CW_PANEL2 + 256 * l + 4 * u0.pm + (ln & 3); unsigned sp_ = 0;
                  while (!__all(xb_ld(pf) != 0u)) { __builtin_amdgcn_s_sleep(1); if (++sp_ > XB_SPIN_CAP) break; }
#ifndef HO_NOACQ
                  if (ln == 0) { __builtin_amdgcn_fence(__ATOMIC_ACQUIRE, "agent"); asm volatile("s_waitcnt vmcnt(0)" ::: "memory"); }
#endif
                  }
              __syncthreads(); } }
#endif
#if defined(HO_G3N) && MK_LAUNCH_MODE == 1
            E.wt = 1;
            gemm_phase<Epi<0>, false, StaticOrder>(F.lds, g, S, E, F.wave);
            { Unit u0; if (S.next(0, u0) && is_t0(F.wave)) __hip_atomic_store((unsigned*)(F.ws + WS_CTL) + CW_PANEL + 512 * l + 4 * u0.pm + u0.pn, 1u, __ATOMIC_RELAXED, __HIP_MEMORY_SCOPE_AGENT); }
#else
            gemm_phase<Epi<0>, false, StaticOrder>(F.lds, g, S, E, F.wave);
            SEAM(pb + 6);
#endif
        }
        if (EN(8) && IN(pb + 7)) { RETID();
            int rbase = -1, wword = -1;
#if defined(HO_G3N) && MK_LAUNCH_MODE == 1
            { StaticOrder S; S.init(M, D, F.G, (int)blockIdx.x); Unit u0; if (S.next(0, u0)) { rbase = 256 * u0.pm + 64 * u0.pn; wword = CW_PANEL + 512 * l + 4 * u0.pm; } }
            RETID();
#endif
#if defined(HO_NG2) && defined(HO_P0) && defined(HO_G3N) && MK_LAUNCH_MODE == 1 && !defined(MK_NO_HALFM) && !defined(MK_HALF_STAGGER)
            if (l == 0) { norm_pass<1>(F, ARGP(0), ARGO(), ARGP(2), ARGP(1) + D, ARGP(3) + (size_t)D * NINR, rbase, wword);
                ho_publish(F, CW_NF + (rbase >> 6)); }
#else
            if (l == 0) { norm_pass<1>(F, ARGP(0), ARGO(), ARGP(2), ARGP(1) + D, ARGP(3) + (size_t)D * NINR, rbase, wword); SEAM(pb + 7); }
#endif
            else {
#ifdef MK_XPROBE
                { const int gw = F.vcu * NWAVES + F.wave; for (int m = gw; m < M; m += F.G * NWAVES) for (int j = 0; j < 4; ++j) *((f32x4*)(ARGO() + (size_t)m * D) + F.lane + 64 * j) = *((const f32x4*)(ARGP(0) + (size_t)m * D) + F.lane + 64 * j); }
#else
                norm_pass<2>(F, ARGO(), ARGO(), ARGP(2) + D, nullptr, nullptr, rbase, wword);
#endif
#ifdef MK_TPROBE
                __syncthreads(); TSTAMP(8);
                if (blockIdx.x == 0 && is_t0(F.wave)) { asm volatile("s_waitcnt vmcnt(0)" ::: "memory"); ARGO()[0] = (MK_TPROBE == 99) ? (__uint_as_float(MISC[18]) - 1000.f) * 0.1f : rintf((__uint_as_float(MISC[18]) - (float)MK_TOFF) * 0.5f) * 2.f; }
#endif
            }
        }
    }
#undef PROJ
#undef HN
#undef WIN
#undef WAB
#undef WOUT
#undef IN
#undef SEAM
}

static int g_grid = 0;
static void launch_all(void* const* d_in, void* d_out, void* d_ws, hipStream_t stream, int n_launch_mode) {
    if (g_grid == 0) {
        int dev = 0, cus = 0;
        if (hipGetDevice(&dev) != hipSuccess || hipDeviceGetAttribute(&cus, hipDeviceAttributeMultiprocessorCount, dev) != hipSuccess) { g_grid = -1; return; }
        if (hipFuncSetAttribute((const void*)fwd_kernel, hipFuncAttributeMaxDynamicSharedMemorySize, LDS_BYTES) != hipSuccess) { g_grid = -1; return; }
        int per_cu = 0;
        if (hipOccupancyMaxActiveBlocksPerMultiprocessor(&per_cu, (const void*)fwd_kernel, NTHREADS, LDS_BYTES) != hipSuccess || per_cu < 1) { fprintf(stderr, "occupancy query: %d\n", per_cu); }
        (void)hipGetLastError();
        g_grid = cus;
        if (g_grid != 256) fprintf(stderr, "kernel_launch: grid %d != 256: unsupported\n", g_grid);
    }
    if (g_grid <= 0) return;
#ifndef MK_NO_MEMSET
    (void)hipMemsetAsync((char*)d_ws + WS_CTL, 0, CTL_ZERO_BYTES, stream);
#endif
    Args a{};
    for (int i = 0; i < 12; ++i) a.in[i] = (const float*)d_in[i];
    a.out = (float*)d_out; a.ws = (unsigned char*)d_ws;
    if (n_launch_mode == 1) { a.ph_lo = 0; a.ph_hi = NPHASES; hipLaunchKernelGGL(fwd_kernel, dim3(g_grid), dim3(NTHREADS), LDS_BYTES, stream, a); }
    else for (int k = 0; k < NPHASES; ++k) { a.ph_lo = k; a.ph_hi = k + 1; hipLaunchKernelGGL(fwd_kernel, dim3(g_grid), dim3(NTHREADS), LDS_BYTES, stream, a); }
}
}
#ifndef MK_LAUNCH_MODE
#define MK_LAUNCH_MODE 1
#endif
extern "C" void kernel_launch(void* const* d_in, const int* in_sizes, int n_in, void* d_out, int out_size, void* d_ws, size_t ws_size, hipStream_t stream) {
    mk::launch_all(d_in, d_out, d_ws, stream, MK_LAUNCH_MODE);
}
```
